# Optimizing an MI355X kernel written in HIP

```python
import math
import jax
import jax.numpy as jnp
from jax import lax
import numpy as np

D_MODEL = 1024
BATCH = 4
SEQ = 8192
DEPTH = 2

GRID_W = 64
CTX_LEN = 256
CHUNK = GRID_W
N_EVEN = (DEPTH + 1) // 2
N_ODD = DEPTH // 2
EPS = 1e-6

GDN_HEADS = 4
GDN_DK = 128
GDN_DV = 128
GDN_QK = GDN_HEADS * GDN_DK
GDN_V = GDN_HEADS * GDN_DV
SHORT_CONV = 3

GLA_HEADS = 4
GLA_DK = 64
GLA_DV = 128
GLA_QK = GLA_HEADS * GLA_DK
GLA_V = GLA_HEADS * GLA_DV
GLA_GATE_RANK = 16
GLA_GATE_TAU = 16.0

AB_SIZES = (GDN_QK, GDN_QK, GDN_V, GDN_V, 2 * GDN_HEADS, 2 * GDN_HEADS, GLA_QK, GLA_QK, GLA_V, GLA_V, 2 * GLA_GATE_RANK)
AB_SPLITS = tuple(sum(AB_SIZES[: i + 1]) for i in range(len(AB_SIZES) - 1))
AB_WIDTH = sum(AB_SIZES)
MIX_WIDTH = GDN_V + GLA_V

HY_ORDER = 2
HY_SHORT = 3
HY_EMB = 33
HY_BANDS = (HY_EMB - 1) // 2
HY_HIDDEN = 64
HY_MIN_DECAY = math.log(1e-2) / 1.5
HY_MAX_DECAY = math.log(1e-2) / 0.3
HY_SHIFT = 0.05

D_FF = -(-8 * D_MODEL // (3 * 256)) * 256

kernel_name = 'hybrid_gdn_gla_hyena_prefix_dit'


def rmsnorm(x, gain):
    xf = x.astype(jnp.float32)
    y = xf * lax.rsqrt(jnp.mean(xf * xf, axis=-1, keepdims=True) + EPS)
    return (y * gain.astype(jnp.float32)).astype(x.dtype)


def modulate(x, gain, shift, scale):
    return rmsnorm(x, gain) * (1 + scale) + shift


def head_rmsnorm(o, gain):
    return o * lax.rsqrt(jnp.mean(o * o, axis=-1, keepdims=True) + EPS) * gain.astype(jnp.float32)


def l2norm(u):
    return u * lax.rsqrt(jnp.sum(u * u, axis=-1, keepdims=True) + EPS)


def short_conv(x, w):
    k, l = w.shape[0], x.shape[1]
    xp = jnp.pad(x, ((0, 0), (k // 2, k // 2), (0, 0)))
    return sum(xp[:, j:j + l] * w[j] for j in range(k))


def swiglu(u, w1, w3, w2):
    return (jax.nn.silu(u @ w1) * (u @ w3)) @ w2


def to_chunks(t):
    b, l, hh = t.shape[:3]
    rows = l // GRID_W
    t = t.reshape((b, rows, CHUNK, hh) + t.shape[3:])
    return jnp.moveaxis(t, 3, 1)


def from_chunks(t):
    b, hh, n, cl, d = t.shape
    return jnp.moveaxis(t, 1, 3).reshape(b, n * cl, hh, d)


def run_gdn(q, k, v, g, beta, s0, emit):
    q, k, v, g, beta = map(to_chunks, (q, k, v, g, beta))
    dv = v.shape[-1]
    lower = jnp.tril(jnp.ones((CHUNK, CHUNK), dtype=bool))
    strict = jnp.tril(jnp.ones((CHUNK, CHUNK), dtype=bool), -1)
    gc = jnp.cumsum(g, axis=-1)
    decay = jnp.exp(jnp.where(lower, gc[..., :, None] - gc[..., None, :], -jnp.inf))
    kb = k * beta[..., None]
    lmat = jnp.where(strict, jnp.einsum('bhncd,bhnsd->bhncs', kb, k) * decay, 0.0) + jnp.eye(CHUNK, dtype=k.dtype)
    rhs = jnp.concatenate([v * beta[..., None], kb * jnp.exp(gc)[..., None]], axis=-1)
    sol = lax.linalg.triangular_solve(lmat, rhs, left_side=True, lower=True, unit_diagonal=True)
    u0, kcd = sol[..., :dv], sol[..., dv:]
    kd = k * jnp.exp(gc[..., -1:] - gc)[..., None]
    gl = jnp.exp(gc[..., -1])
    xs = (u0, kcd, kd, gl)
    if emit:
        attn = jnp.einsum('bhncd,bhnsd->bhncs', q, k) * decay
        xs = xs + (attn, q * jnp.exp(gc)[..., None])
    xs = tuple(jnp.moveaxis(t, 2, 0) for t in xs)

    def step(s, inp):
        u0_i, kcd_i, kd_i, gl_i = inp[:4]
        u = u0_i - jnp.einsum('bhcd,bhde->bhce', kcd_i, s)
        s_new = s * gl_i[..., None, None] + jnp.einsum('bhcd,bhce->bhde', kd_i, u)
        if not emit:
            return s_new, None
        attn_i, qd_i = inp[4:]
        o = jnp.einsum('bhcd,bhde->bhce', qd_i, s) + jnp.einsum('bhcs,bhse->bhce', attn_i, u)
        return s_new, o

    s_fin, out = lax.scan(step, s0, xs)
    out = from_chunks(jnp.moveaxis(out, 0, 2)) if emit else None
    return out, s_fin


def run_gla(q, k, v, log_a, s0, emit):
    q, k, v, log_a = map(to_chunks, (q, k, v, log_a))
    bc = jnp.cumsum(log_a, axis=-2)
    kd = k * jnp.exp(bc[..., -1:, :] - bc)
    gl = jnp.exp(bc[..., -1, :])
    xs = (kd, v, gl)
    if emit:
        lower = jnp.tril(jnp.ones((CHUNK, CHUNK), dtype=bool))
        ref = bc[..., CHUNK // 2:CHUNK // 2 + 1, :]
        attn = jnp.einsum('bhncd,bhnsd->bhncs', q * jnp.exp(bc - ref), k * jnp.exp(ref - bc))
        attn = jnp.where(lower, attn, 0.0)
        intra = jnp.einsum('bhncs,bhnse->bhnce', attn, v)
        xs = xs + (q * jnp.exp(bc),)
    xs = tuple(jnp.moveaxis(t, 2, 0) for t in xs)

    def step(s, inp):
        kd_i, v_i, gl_i = inp[:3]
        s_new = s * gl_i[..., :, None] + jnp.einsum('bhcd,bhce->bhde', kd_i, v_i)
        if not emit:
            return s_new, None
        o = jnp.einsum('bhcd,bhde->bhce', inp[3], s)
        return s_new, o

    s_fin, inter = lax.scan(step, s0, xs)
    out = from_chunks(jnp.moveaxis(inter, 0, 2) + intra) if emit else None
    return out, s_fin


def orient(t, d):
    return t if d == 0 else jnp.flip(t, axis=1)


def bidirectional(run, ctx_dirs, lat_dirs, s0, ctx_out):
    lat_outs, ctx_outs = [], []
    for d in range(2):
        oc, s_ctx = run(*[orient(t, d) for t in ctx_dirs[d]], s0, ctx_out)
        ol, _ = run(*[orient(t, d) for t in lat_dirs[d]], s_ctx, True)
        lat_outs.append(orient(ol, d))
        if ctx_out:
            ctx_outs.append(orient(oc, d))
    return lat_outs[0] + lat_outs[1], (ctx_outs[0] + ctx_outs[1] if ctx_out else None)


def ab_prepare(t, w_in, conv_w, a_log, dt_bias, gla_gate_w, gla_gate_b):
    b, l, _ = t.shape
    f32 = jnp.float32
    gq, gk, gv, gz, ga, gb, lq, lk, lv, lg, llr = jnp.split(t @ w_in, AB_SPLITS, axis=-1)
    qkv = jax.nn.silu(short_conv(jnp.concatenate([gq, gk, gv], axis=-1), conv_w)).astype(f32)
    gq, gk, gv = jnp.split(qkv, (GDN_QK, 2 * GDN_QK), axis=-1)

    def heads(u, h, d):
        return u.astype(f32).reshape(b, l, h, d)

    gate = jnp.einsum('bldr,drk->bldk', heads(llr, 2, GLA_GATE_RANK), gla_gate_w.astype(f32)) + gla_gate_b.astype(f32)
    return dict(
        gdn_q=l2norm(heads(gq, GDN_HEADS, GDN_DK)) * GDN_DK ** -0.5,
        gdn_k=l2norm(heads(gk, GDN_HEADS, GDN_DK)),
        gdn_v=heads(gv, GDN_HEADS, GDN_DV),
        gdn_g=-jnp.exp(a_log.astype(f32)) * jax.nn.softplus(heads(ga, 2, GDN_HEADS) + dt_bias.astype(f32)),
        gdn_beta=jax.nn.sigmoid(heads(gb, 2, GDN_HEADS)),
        gdn_z=heads(gz, GDN_HEADS, GDN_DV),
        gla_q=heads(lq, GLA_HEADS, GLA_DK) * GLA_DK ** -0.5,
        gla_k=heads(lk, GLA_HEADS, GLA_DK),
        gla_v=heads(lv, GLA_HEADS, GLA_DV),
        gla_log_a=(jax.nn.log_sigmoid(gate) / GLA_GATE_TAU).reshape(b, l, 2, GLA_HEADS, GLA_DK),
        gla_g=heads(lg, GLA_HEADS, GLA_DV),
    )


def ab_mixer(a, ac, w_in, conv_w, a_log, dt_bias, gdn_norm_w, gla_gate_w, gla_gate_b, gla_norm_w, w_out, ctx_out):
    pl = ab_prepare(a, w_in, conv_w, a_log, dt_bias, gla_gate_w, gla_gate_b)
    pc = ab_prepare(ac, w_in, conv_w, a_log, dt_bias, gla_gate_w, gla_gate_b)
    b = a.shape[0]
    s0_gdn = jnp.zeros((b, GDN_HEADS, GDN_DK, GDN_DV), jnp.float32)
    s0_gla = jnp.zeros((b, GLA_HEADS, GLA_DK, GLA_DV), jnp.float32)

    def gdn_dir(p, d):
        return (p['gdn_q'], p['gdn_k'], p['gdn_v'], p['gdn_g'][:, :, d], p['gdn_beta'][:, :, d])

    def gla_dir(p, d):
        return (p['gla_q'], p['gla_k'], p['gla_v'], p['gla_log_a'][:, :, d])

    o_gdn, oc_gdn = bidirectional(run_gdn, [gdn_dir(pc, d) for d in range(2)], [gdn_dir(pl, d) for d in range(2)], s0_gdn, ctx_out)
    o_gla, oc_gla = bidirectional(run_gla, [gla_dir(pc, d) for d in range(2)], [gla_dir(pl, d) for d in range(2)], s0_gla, ctx_out)

    def merge(og, ol, p, dtype):
        bb, l = og.shape[:2]
        y_gdn = (head_rmsnorm(og, gdn_norm_w) * jax.nn.silu(p['gdn_z'])).reshape(bb, l, GDN_V)
        y_gla = (head_rmsnorm(ol, gla_norm_w) * jax.nn.silu(p['gla_g'])).reshape(bb, l, GLA_V)
        return jnp.concatenate([y_gdn, y_gla], axis=-1).astype(dtype) @ w_out

    m = merge(o_gdn, o_gla, pl, a.dtype)
    mc = merge(oc_gdn, oc_gla, pc, ac.dtype) if ctx_out else None
    return m, mc


def hyena_filters(l, w1, b1, w2, b2, w3, b3, freq, filt_out):
    f32 = jnp.float32
    t = jnp.linspace(0.0, 1.0, l, dtype=f32)[:, None]
    w = (2.0 * math.pi / l) * jnp.arange(l, dtype=f32)[:, None]
    f = jnp.linspace(1e-4, HY_BANDS - 1, HY_BANDS, dtype=f32)[None, :]
    z = jnp.concatenate([t, jnp.cos(f * w), -jnp.sin(f * w)], axis=-1)
    fr = freq.astype(f32)
    hdn = jnp.sin(fr * (z @ w1.astype(f32) + b1.astype(f32)))
    hdn = jnp.sin(fr * (hdn @ w2.astype(f32) + b2.astype(f32)))
    hdn = jnp.sin(fr * (hdn @ w3.astype(f32) + b3.astype(f32)))
    h = (hdn @ filt_out.astype(f32)).reshape(l, 2, HY_ORDER, D_MODEL)
    deltas = jnp.abs(jnp.linspace(HY_MIN_DECAY, HY_MAX_DECAY, D_MODEL, dtype=f32))
    window = jnp.exp(-t.reshape(l, 1, 1, 1) * deltas) + HY_SHIFT
    return h * window


def long_conv(z, h_fwd, h_bwd, skip):
    l = z.shape[1]
    k = jnp.concatenate([h_fwd, jnp.zeros_like(h_fwd[:1]), jnp.flip(h_bwd[1:], axis=0)], axis=0)
    y = jnp.fft.irfft(jnp.fft.rfft(z, n=2 * l, axis=1) * jnp.fft.rfft(k, axis=0)[None], n=2 * l, axis=1)[:, :l]
    return y + z * skip.astype(jnp.float32)


def hyena_mixer(a, w_in, conv_w, w1, b1, w2, b2, w3, b3, freq, filt_out, skip, w_out):
    l = a.shape[1]
    u = short_conv(a @ w_in, conv_w).astype(jnp.float32)
    v, x1, x2 = jnp.split(u, 3, axis=-1)
    filt = hyena_filters(l, w1, b1, w2, b2, w3, b3, freq, filt_out)
    z = v
    for n, gate in enumerate((x1, x2)):
        z = gate * long_conv(z, filt[:, 0, n], filt[:, 1, n], skip[n])
    return z.astype(a.dtype) @ w_out


def setup_inputs(seed: int = 0) -> dict:
    key = jax.random.key(seed)
    ks = iter(jax.random.split(key, 40))
    f32 = jnp.float32
    D = D_MODEL

    def nrm(shape, scale):
        return jax.random.normal(next(ks), shape, f32) * scale

    dt = jnp.exp(jax.random.uniform(next(ks), (N_EVEN, 2, GDN_HEADS), f32, math.log(1e-3), math.log(1e-1)))
    return {
        'x': nrm((BATCH, SEQ, D), 1.0),
        'c': nrm((BATCH, D), 1.0),
        'ctx': nrm((BATCH, CTX_LEN, D), 1.0),
        'c_ctx': nrm((D,), 1.0),
        'mod_w': nrm((DEPTH, D, 6 * D), 0.5 * D ** -0.5),
        'mod_b': nrm((DEPTH, 6 * D), 0.02),
        'norm1_w': 1.0 + nrm((DEPTH, D), 0.02),
        'norm2_w': 1.0 + nrm((DEPTH, D), 0.02),
        'ab_w_in': nrm((N_EVEN, D, AB_WIDTH), D ** -0.5),
        'ab_conv_w': nrm((N_EVEN, SHORT_CONV, 2 * GDN_QK + GDN_V), SHORT_CONV ** -0.5),
        'gdn_a_log': jnp.log(jax.random.uniform(next(ks), (N_EVEN, 2, GDN_HEADS), f32, 1.0, 16.0)),
        'gdn_dt_bias': dt + jnp.log(-jnp.expm1(-dt)),
        'gdn_norm_w': 1.0 + nrm((N_EVEN, GDN_DV), 0.02),
        'gla_gate_w': nrm((N_EVEN, 2, GLA_GATE_RANK, GLA_QK), GLA_GATE_RANK ** -0.5),
        'gla_gate_b': nrm((N_EVEN, 2, GLA_QK), 0.1),
        'gla_norm_w': 1.0 + nrm((N_EVEN, GLA_DV), 0.02),
        'ab_w_out': nrm((N_EVEN, MIX_WIDTH, D), MIX_WIDTH ** -0.5),
        'hy_w_in': nrm((N_ODD, D, 3 * D), D ** -0.5),
        'hy_conv_w': nrm((N_ODD, HY_SHORT, 3 * D), HY_SHORT ** -0.5),
        'hy_pos_w1': nrm((N_ODD, HY_EMB, HY_HIDDEN), HY_EMB ** -0.5),
        'hy_pos_b1': nrm((N_ODD, HY_HIDDEN), 0.1),
        'hy_pos_w2': nrm((N_ODD, HY_HIDDEN, HY_HIDDEN), HY_HIDDEN ** -0.5),
        'hy_pos_b2': nrm((N_ODD, HY_HIDDEN), 0.1),
        'hy_pos_w3': nrm((N_ODD, HY_HIDDEN, HY_HIDDEN), HY_HIDDEN ** -0.5),
        'hy_pos_b3': nrm((N_ODD, HY_HIDDEN), 0.1),
        'hy_freq': 1.0 + nrm((N_ODD, HY_HIDDEN), 0.02),
        'hy_filt_out': nrm((N_ODD, HY_HIDDEN, 2 * HY_ORDER * D), 0.03 * HY_HIDDEN ** -0.5),
        'hy_skip': nrm((N_ODD, HY_ORDER, D), 0.5),
        'hy_w_out': nrm((N_ODD, D, D), D ** -0.5),
        'ffn_w1': nrm((DEPTH, D, D_FF), D ** -0.5),
        'ffn_w3': nrm((DEPTH, D, D_FF), D ** -0.5),
        'ffn_w2': nrm((DEPTH, D_FF, D), D_FF ** -0.5),
        'final_norm_w': 1.0 + nrm((D,), 0.02),
    }


def reference(x, c, ctx, c_ctx, mod_w, mod_b, norm1_w, norm2_w, ab_w_in, ab_conv_w, gdn_a_log, gdn_dt_bias,
              gdn_norm_w, gla_gate_w, gla_gate_b, gla_norm_w, ab_w_out, hy_w_in, hy_conv_w, hy_pos_w1, hy_pos_b1,
              hy_pos_w2, hy_pos_b2, hy_pos_w3, hy_pos_b3, hy_freq, hy_filt_out, hy_skip, hy_w_out,
              ffn_w1, ffn_w3, ffn_w2, final_norm_w):
    silu_c = jax.nn.silu(c)
    silu_cc = jax.nn.silu(c_ctx)
    h, hc = x, ctx
    for i in range(DEPTH):
        even = i % 2 == 0
        ctx_carry = any(j % 2 == 0 for j in range(i + 1, DEPTH))
        ctx_read = even or ctx_carry
        sh1, sc1, g1, sh2, sc2, g2 = jnp.split((silu_c @ mod_w[i] + mod_b[i])[:, None, :], 6, axis=-1)
        a = modulate(h, norm1_w[i], sh1, sc1)
        if ctx_read:
            csh1, csc1, cg1, csh2, csc2, cg2 = jnp.split(silu_cc @ mod_w[i] + mod_b[i], 6, axis=-1)
            ac = modulate(hc, norm1_w[i], csh1, csc1)
        if even:
            e = i // 2
            m, mc = ab_mixer(a, ac, ab_w_in[e], ab_conv_w[e], gdn_a_log[e], gdn_dt_bias[e], gdn_norm_w[e],
                             gla_gate_w[e], gla_gate_b[e], gla_norm_w[e], ab_w_out[e], ctx_carry)
        else:
            o = i // 2
            hy = (hy_w_in[o], hy_conv_w[o], hy_pos_w1[o], hy_pos_b1[o], hy_pos_w2[o], hy_pos_b2[o],
                  hy_pos_w3[o], hy_pos_b3[o], hy_freq[o], hy_filt_out[o], hy_skip[o], hy_w_out[o])
            m = hyena_mixer(a, *hy)
            mc = hyena_mixer(ac, *hy) if ctx_carry else None
        h = h + g1 * m
        h = h + g2 * swiglu(modulate(h, norm2_w[i], sh2, sc2), ffn_w1[i], ffn_w3[i], ffn_w2[i])
        if ctx_carry:
            hc = hc + cg1 * mc
            hc = hc + cg2 * swiglu(modulate(hc, norm2_w[i], csh2, csc2), ffn_w1[i], ffn_w3[i], ffn_w2[i])
    return rmsnorm(h, final_norm_w)
```

```cpp
#include <hip/hip_runtime.h>
#include <hip/hip_cooperative_groups.h>
#include <cstdio>
#include <cmath>
namespace cg = cooperative_groups;

#define PG8_LAS __attribute__((address_space(3)))
typedef unsigned short bf16_t;
typedef short bf16x8 __attribute__((ext_vector_type(8)));
typedef float f32x4 __attribute__((ext_vector_type(4)));
typedef float f32x2 __attribute__((ext_vector_type(2)));
typedef unsigned u32x4 __attribute__((ext_vector_type(4)));
typedef unsigned u32x2 __attribute__((ext_vector_type(2)));
#define DI __device__ __forceinline__

typedef __bf16 bf16v2_t __attribute__((ext_vector_type(2)));
DI unsigned cvt_pk_bf16(float lo, float hi) { return __builtin_bit_cast(unsigned, __builtin_convertvector((f32x2){lo, hi}, bf16v2_t)); }
DI bf16_t f2bf(float x) { return (bf16_t)(cvt_pk_bf16(x, 0.f) & 0xffffu); }
DI float bf2f(bf16_t v) { return __uint_as_float(((unsigned)v) << 16); }
DI float bflo(unsigned w) { return __uint_as_float(w << 16); }
DI float bfhi(unsigned w) { return __uint_as_float(w & 0xffff0000u); }
DI float siluf(float x) { return x * __builtin_amdgcn_rcpf(1.f + __expf(-x)); }
DI float sigmoidf_(float x) { return __builtin_amdgcn_rcpf(1.f + __expf(-x)); }

namespace pg8 {
constexpr int BM = 256, BK = 64, HALF = 128, HTB = HALF * BK * 2, STAGE_BYTES = 8 * HTB, NXCD = 8, WGM = 4;
__host__ __device__ __forceinline__ int lds_byte(int r, int c) { const int st = (r >> 4) * 2 + (c >> 5), rr = r & 15, cc = c & 31, ob = rr * 64 + cc * 2; return st * 1024 + (ob ^ (((ob >> 9) & 1) << 5)); }
__host__ __device__ __forceinline__ void stage_rc(int b, int& R, int& C) { const int st = b / 1024, sb = b % 1024, swz = sb ^ (((sb >> 9) & 1) << 5); R = (st >> 1) * 16 + swz / 64; C = (st & 1) * 32 + (swz % 64) / 2; }
__host__ __device__ __forceinline__ int perm32(int rho) { const int n = rho >> 4, i = rho & 15; return 8 * (i >> 2) + 4 * n + (i & 3); }

struct Unit { int pm, pn; };
struct Gemm { const bf16_t* A; const bf16_t* Bt; int M, N, K; };

struct StaticOrder {
    int nM, nN, nwg, G, c;
    __host__ __device__ void init(int M, int N, int G_, int c_) { nM = M / BM; nN = N / BM; nwg = nM * nN; G = G_; c = c_; }
    __host__ __device__ bool next(int i, Unit& u) const {
        const long L = (long)i * G + c; if (L >= nwg) return false;
        int wgid = (int)L; { const int q = nwg / NXCD, r = nwg % NXCD, xcd = wgid % NXCD, off = wgid / NXCD; wgid = (xcd < r ? xcd * (q + 1) : r * (q + 1) + (xcd - r) * q) + off; }
        const int nig = WGM * nN, gid = wgid / nig, fm = gid * WGM, gsz = (nM - fm) < WGM ? (nM - fm) : WGM;
        u.pm = fm + ((wgid % nig) % gsz); u.pn = (wgid % nig) / gsz; return true;
    }
    __device__ __forceinline__ void a_ready(const Unit&) const {}
    __device__ __forceinline__ void done(const Unit&) const {}
};
template <class Epi, class Sched, bool ALIGN_EPI = false, bool SP2 = false>
__device__ __forceinline__ void gemm_phase(PG8_LAS unsigned char* lds, const Gemm g, const Sched& S, const Epi& E) {
    const int tid = threadIdx.x, wid = __builtin_amdgcn_readfirstlane(tid >> 6), lane = tid & 63, wr = wid >> 2, wc = wid & 3, fr = lane & 15, fq = lane >> 4;
    const int K = g.K, nt = K / BK;
    unsigned voffA[2], voffB[2];
#pragma unroll
    for (int i = 0; i < 2; ++i) { int R, C; stage_rc(tid * 16 + i * 8192, R, C); const int Rb = Epi::PERM ? ((R & ~31) + perm32(R & 31)) : R;
        voffA[i] = (unsigned)(R * K + C) * 2u; voffB[i] = (unsigned)(Rb * K + C) * 2u; }
    const size_t kstep = (size_t)(BK * 2);
    const size_t hstep = (size_t)HALF * K * 2;
    const size_t tstep = 2 * hstep;
    const unsigned ldsw = (unsigned)wid * 1024u;
    const int aoff = lds_byte(wr * 64 + fr, fq * 8), boff = lds_byte(wc * 32 + fr, fq * 8);
#define PG8_SA(b, h) (((b) * 2 + (h)) * HTB)
#define PG8_SB(b, h) ((4 + (b) * 2 + (h)) * HTB)
#define PG8_STAGE(bufoff, gbase, voff) do { _Pragma("unroll") for (int _i = 0; _i < 2; ++_i) \
        __builtin_amdgcn_global_load_lds((const unsigned*)((const char*)(gbase) + (voff)[_i]), (PG8_LAS unsigned*)(lds + (bufoff) + ldsw + _i * 8192), 16, 0, 0); } while (0)
#define PG8_LDA(dst, b, h) do { _Pragma("unroll") for (int m = 0; m < 4; ++m) _Pragma("unroll") for (int k = 0; k < 2; ++k) dst[m][k] = *(const PG8_LAS bf16x8*)(lds + PG8_SA(b, h) + aoff + m * 2048 + k * 1024); } while (0)
#define PG8_LDB(dst, b, h) do { _Pragma("unroll") for (int n = 0; n < 2; ++n) _Pragma("unroll") for (int k = 0; k < 2; ++k) dst[n][k] = *(const PG8_LAS bf16x8*)(lds + PG8_SB(b, h) + boff + n * 2048 + k * 1024); } while (0)
#define PG8_MMA(ai, bj, At, Bt) do { __builtin_amdgcn_s_setprio(1); _Pragma("unroll") for (int m = 0; m < 4; ++m) _Pragma("unroll") for (int n = 0; n < 2; ++n) _Pragma("unroll") for (int k = 0; k < 2; ++k) \
        acc[ai][bj][m][n] = __builtin_amdgcn_mfma_f32_16x16x32_bf16(Bt[n][k], At[m][k], acc[ai][bj][m][n], 0, 0, 0); __builtin_amdgcn_s_setprio(0); } while (0)
#define PG8_WAIT_V(n) asm volatile("s_waitcnt vmcnt(" #n ")" ::: "memory")
#define PG8_WAIT_L(n) asm volatile("s_waitcnt lgkmcnt(" #n ")" ::: "memory")
#define PG8_BAR __builtin_amdgcn_s_barrier()
#define PG8_SCHED __builtin_amdgcn_sched_barrier(0)
    Unit cur, nxt; int ui = 0;
    if (!S.next(0, cur)) return;
    f32x4 acc[2][2][4][2];
#pragma unroll
    for (int a = 0; a < 2; ++a)
#pragma unroll
        for (int b = 0; b < 2; ++b)
#pragma unroll
            for (int m = 0; m < 4; ++m)
#pragma unroll
                for (int n = 0; n < 2; ++n) acc[a][b][m][n] = (f32x4){0.f, 0.f, 0.f, 0.f};
    bf16x8 At[4][2], B0[2][2], B1[2][2];
    const char* cA = (const char*)g.A + (size_t)cur.pm * tstep; const char* cB = (const char*)g.Bt + (size_t)cur.pn * tstep;
    S.a_ready(cur);
    if constexpr (SP2) {
        PG8_STAGE(PG8_SB(0, 0), cB, voffB); PG8_STAGE(PG8_SB(0, 1), cB + hstep, voffB); PG8_STAGE(PG8_SA(0, 0), cA, voffA); PG8_STAGE(PG8_SA(0, 1), cA + hstep, voffA);
        if (wr == 1) PG8_BAR;
        PG8_WAIT_V(2); PG8_BAR;
        PG8_STAGE(PG8_SB(1, 0), cB + kstep, voffB); PG8_STAGE(PG8_SA(1, 0), cA + kstep, voffA); PG8_STAGE(PG8_SB(1, 1), cB + hstep + kstep, voffB);
        PG8_WAIT_V(6); PG8_BAR;
    } else {
        PG8_STAGE(PG8_SB(0, 0), cB, voffB); PG8_STAGE(PG8_SA(0, 0), cA, voffA); PG8_STAGE(PG8_SB(0, 1), cB + hstep, voffB); PG8_STAGE(PG8_SA(0, 1), cA + hstep, voffA);
        if (wr == 1) PG8_BAR;
        PG8_WAIT_V(4); PG8_BAR;
        PG8_STAGE(PG8_SB(1, 0), cB + kstep, voffB); PG8_STAGE(PG8_SA(1, 0), cA + kstep, voffA); PG8_STAGE(PG8_SB(1, 1), cB + hstep + kstep, voffB);
        PG8_WAIT_V(6); PG8_BAR;
    }
    for (;;) {
        const bool has_next = S.next(ui + 1, nxt);
        const char* nA = has_next ? (const char*)g.A + (size_t)nxt.pm * tstep : cA; const char* nB = has_next ? (const char*)g.Bt + (size_t)nxt.pn * tstep : cB;
        for (int t = 0; t < nt; t += 2) {
            const bool last = (t == nt - 2);
            const char* a1 = cA + (size_t)(t + 1) * kstep;
            const char* a2 = last ? nA : cA + (size_t)(t + 2) * kstep; const char* b2 = last ? nB : cB + (size_t)(t + 2) * kstep;
            const char* a3 = a2 + kstep; const char* b3 = b2 + kstep;
            if (last && has_next) S.a_ready(nxt);
            if constexpr (SP2) {
            PG8_LDB(B0, 0, 0); PG8_LDB(B1, 0, 1); PG8_SCHED; PG8_LDA(At, 0, 0); PG8_STAGE(PG8_SA(1, 1), a1 + hstep, voffA);
            PG8_WAIT_V(8); PG8_WAIT_L(0); PG8_BAR; PG8_MMA(0, 0, At, B0); PG8_MMA(0, 1, At, B1); PG8_BAR; PG8_SCHED;
            PG8_LDA(At, 0, 1); PG8_STAGE(PG8_SB(0, 0), b2, voffB); PG8_STAGE(PG8_SB(0, 1), b2 + hstep, voffB); PG8_STAGE(PG8_SA(0, 0), a2, voffA);
            PG8_WAIT_V(8); PG8_WAIT_L(0); PG8_BAR; PG8_MMA(1, 0, At, B0); PG8_MMA(1, 1, At, B1); PG8_BAR; PG8_SCHED;
            PG8_LDB(B0, 1, 0); PG8_LDB(B1, 1, 1); PG8_SCHED; PG8_LDA(At, 1, 0); PG8_STAGE(PG8_SA(0, 1), a2 + hstep, voffA);
            PG8_WAIT_V(8); PG8_WAIT_L(0); PG8_BAR; PG8_MMA(0, 0, At, B0); PG8_MMA(0, 1, At, B1); PG8_BAR; PG8_SCHED;
            PG8_LDA(At, 1, 1); PG8_STAGE(PG8_SB(1, 0), b3, voffB); PG8_STAGE(PG8_SB(1, 1), b3 + hstep, voffB); PG8_STAGE(PG8_SA(1, 0), a3, voffA);
            PG8_WAIT_V(8); PG8_WAIT_L(0); PG8_BAR; PG8_MMA(1, 0, At, B0); PG8_MMA(1, 1, At, B1); PG8_BAR; PG8_SCHED;
            } else {
            PG8_LDB(B0, 0, 0); PG8_SCHED; PG8_LDA(At, 0, 0); PG8_STAGE(PG8_SA(1, 1), a1 + hstep, voffA);
            PG8_WAIT_L(8); PG8_BAR; PG8_WAIT_L(0); PG8_MMA(0, 0, At, B0); PG8_BAR; PG8_SCHED;
            PG8_LDB(B1, 0, 1); PG8_STAGE(PG8_SB(0, 0), b2, voffB);
            PG8_BAR; PG8_WAIT_L(0); PG8_MMA(0, 1, At, B1); PG8_BAR;
            PG8_LDA(At, 0, 1); PG8_STAGE(PG8_SA(0, 0), a2, voffA);
            PG8_BAR; PG8_WAIT_L(0); PG8_MMA(1, 0, At, B0); PG8_BAR; PG8_SCHED;
            PG8_STAGE(PG8_SB(0, 1), b2 + hstep, voffB);
            PG8_WAIT_V(6); PG8_BAR; PG8_MMA(1, 1, At, B1); PG8_BAR;
            PG8_LDB(B0, 1, 0); PG8_SCHED; PG8_LDA(At, 1, 0); PG8_STAGE(PG8_SA(0, 1), a2 + hstep, voffA);
            PG8_WAIT_L(8); PG8_BAR; PG8_WAIT_L(0); PG8_MMA(0, 0, At, B0); PG8_BAR; PG8_SCHED;
            PG8_LDB(B1, 1, 1); PG8_STAGE(PG8_SB(1, 0), b3, voffB);
            PG8_BAR; PG8_WAIT_L(0); PG8_MMA(0, 1, At, B1); PG8_BAR;
            PG8_LDA(At, 1, 1); PG8_STAGE(PG8_SA(1, 0), a3, voffA);
            PG8_BAR; PG8_WAIT_L(0); PG8_MMA(1, 0, At, B0); PG8_BAR; PG8_SCHED;
            PG8_STAGE(PG8_SB(1, 1), b3 + hstep, voffB);
            PG8_WAIT_V(6); PG8_BAR; PG8_MMA(1, 1, At, B1); PG8_BAR;
            }
        }
        if constexpr (ALIGN_EPI) { if (wr == 0) PG8_BAR; }
        if constexpr (!Epi::AFTER_DRAIN) { E(acc, cur, wr, wc, fr, fq); S.done(cur); }
        if (!has_next) break;
#pragma unroll
        for (int a = 0; a < 2; ++a)
#pragma unroll
            for (int b = 0; b < 2; ++b)
#pragma unroll
                for (int m = 0; m < 4; ++m)
#pragma unroll
                    for (int n = 0; n < 2; ++n) acc[a][b][m][n] = (f32x4){0.f, 0.f, 0.f, 0.f};
        cur = nxt; cA = nA; cB = nB; ++ui;
        if constexpr (ALIGN_EPI) { if (wr == 1) PG8_BAR; }
    }
    PG8_WAIT_V(0);
    if constexpr (!ALIGN_EPI) { if (wr == 0) PG8_BAR; }
    PG8_BAR;
    if constexpr (Epi::AFTER_DRAIN) { E.fused(acc, cur, wr, wc, fr, fq, lds, wid, lane); S.done(cur); }
#undef PG8_SA
#undef PG8_SB
#undef PG8_STAGE
#undef PG8_LDA
#undef PG8_LDB
#undef PG8_MMA
#undef PG8_WAIT_V
#undef PG8_WAIT_L
#undef PG8_BAR
#undef PG8_SCHED
}
}
namespace pg8 {
struct EpiAbIn {
    static constexpr bool PERM = true, AFTER_DRAIN = false;
    bf16_t* R; bf16_t* P2; float* G;
    DI void operator()(const f32x4 (&acc)[2][2][4][2], const Unit& u, int wr, int wc, int fr, int fq) const {
        const int row0 = u.pm * BM + wr * 64 + fr;
#pragma unroll
        for (int ai = 0; ai < 2; ++ai)
#pragma unroll
            for (int m = 0; m < 4; ++m) { const size_t row = (size_t)(row0 + ai * HALF + m * 16);
#pragma unroll
                for (int bj = 0; bj < 2; ++bj) { const int cc = bj * HALF + wc * 32 + 8 * fq; const f32x4 v0 = acc[ai][bj][m][0], v1 = acc[ai][bj][m][1];
                    if (u.pn < 14) { u32x4 w; w.x = cvt_pk_bf16(v0[0], v0[1]); w.y = cvt_pk_bf16(v0[2], v0[3]); w.z = cvt_pk_bf16(v1[0], v1[1]); w.w = cvt_pk_bf16(v1[2], v1[3]);
                        if (u.pn < 6) *(u32x4*)(R + row * 1536 + u.pn * 256 + cc) = w; else *(u32x4*)(P2 + row * 2048 + (u.pn - 6) * 256 + cc) = w; }
                    else if (cc < 48) { *(f32x4*)(G + row * 64 + cc) = v0; *(f32x4*)(G + row * 64 + cc + 4) = v1; } } }
    }
};
struct EpiResid {
    static constexpr bool PERM = false, AFTER_DRAIN = false;
    float* out; const float* resid; const float* gate;
    DI void operator()(const f32x4 (&acc)[2][2][4][2], const Unit& u, int wr, int wc, int fr, int fq) const {
        const int row0 = u.pm * BM + wr * 64 + fr, col0 = u.pn * BM + wc * 32 + 4 * fq;
#pragma unroll
        for (int ai = 0; ai < 2; ++ai)
#pragma unroll
            for (int m = 0; m < 4; ++m) { const size_t row = (size_t)(row0 + ai * HALF + m * 16); const float* gp = gate + (row >> 13) * 6144;
#pragma unroll
                for (int bj = 0; bj < 2; ++bj)
#pragma unroll
                    for (int n = 0; n < 2; ++n) { const int col = col0 + bj * HALF + n * 16; const f32x4 g = *(const f32x4*)(gp + col); const f32x4 r = *(const f32x4*)(resid + row * 1024 + col);
                        *(f32x4*)(out + row * 1024 + col) = r + g * acc[ai][bj][m][n]; }
                asm volatile("" ::: "memory"); }
    }
};
struct EpiSwiglu {
    static constexpr bool PERM = false, AFTER_DRAIN = false;
    bf16_t* hid;
    DI void operator()(const f32x4 (&acc)[2][2][4][2], const Unit& u, int wr, int wc, int fr, int fq) const {
        const int row0 = u.pm * BM + wr * 64 + fr, col0 = u.pn * 128 + wc * 16 + 4 * fq;
#pragma unroll
        for (int ai = 0; ai < 2; ++ai)
#pragma unroll
            for (int m = 0; m < 4; ++m) { const size_t row = (size_t)(row0 + ai * HALF + m * 16);
#pragma unroll
                for (int bj = 0; bj < 2; ++bj) { const f32x4 a = acc[ai][bj][m][0], b = acc[ai][bj][m][1];
                    u32x2 w; w.x = cvt_pk_bf16(siluf(a[0]) * b[0], siluf(a[1]) * b[1]); w.y = cvt_pk_bf16(siluf(a[2]) * b[2], siluf(a[3]) * b[3]);
                    *(u32x2*)(hid + row * 2816 + col0 + bj * 64) = w; } }
    }
};
struct EpiBf16Plain {
    static constexpr bool PERM = true, AFTER_DRAIN = false;
    bf16_t* O; size_t ldc;
    DI void operator()(const f32x4 (&acc)[2][2][4][2], const Unit& u, int wr, int wc, int fr, int fq) const {
        const int row0 = u.pm * BM + wr * 64 + fr, col0 = u.pn * BM + wc * 32 + 8 * fq;
#pragma unroll
        for (int ai = 0; ai < 2; ++ai)
#pragma unroll
            for (int m = 0; m < 4; ++m) { bf16_t* rowp = O + (size_t)(row0 + ai * HALF + m * 16) * ldc + col0;
#pragma unroll
                for (int bj = 0; bj < 2; ++bj) { const f32x4 v0 = acc[ai][bj][m][0], v1 = acc[ai][bj][m][1];
                    u32x4 w; w.x = cvt_pk_bf16(v0[0], v0[1]); w.y = cvt_pk_bf16(v0[2], v0[3]); w.z = cvt_pk_bf16(v1[0], v1[1]); w.w = cvt_pk_bf16(v1[2], v1[3]);
                    *(u32x4*)(rowp + bj * HALF) = w; } }
    }
};
}
constexpr int T_LAT = 32768, T_CTX = 1024, T_ALL = 33792, DM = 1024, DFF = 2816, SEQ = 8192;
constexpr size_t MiB = 1048576;
constexpr size_t OFF_MODV = 0;
constexpr size_t OFF_W0 = MiB / 4;
constexpr size_t OFF_W0_ABIN = OFF_W0, OFF_W0_ABOUT = OFF_W0_ABIN + 3840ull * 1024 * 2, OFF_W0_F1 = OFF_W0_ABOUT + 1024ull * 1024 * 2, OFF_W0_F2 = OFF_W0_F1 + 5632ull * 1024 * 2;
constexpr size_t OFF_G = OFF_W0 + 26 * MiB;
constexpr size_t OFF_A = OFF_G + 8 * MiB + MiB / 4;
constexpr size_t OFF_R = OFF_A + 66 * MiB;
constexpr size_t OFF_P2 = OFF_R + 99 * MiB;
constexpr size_t OFF_PD = OFF_P2 + 132 * MiB;
constexpr size_t OFF_U0T = OFF_PD, OFF_KCD = OFF_U0T + 66 * MiB, OFF_ATT = OFF_KCD + 66 * MiB, OFF_GC = OFF_ATT + 33 * MiB;
constexpr size_t OFF_OGDN = OFF_A, OFF_OGLA = OFF_A + 64 * MiB;
constexpr size_t OFF_Y = OFF_PD;
constexpr size_t OFF_W1 = OFF_A + 450 * MiB;
constexpr size_t OFF_W1_HYIN = OFF_W1, OFF_W1_HYOUT = OFF_W1_HYIN + 3072ull * 1024 * 2, OFF_W1_F1 = OFF_W1_HYOUT + 1024ull * 1024 * 2, OFF_W1_F2 = OFF_W1_F1 + 5632ull * 1024 * 2;
constexpr size_t OFF_HID = OFF_R;
constexpr size_t OFF_UT = OFF_R;
constexpr size_t OFF_HT = OFF_R;
constexpr size_t OFF_SPEC = OFF_UT + 192 * MiB;
constexpr size_t OFF_ZT = OFF_SPEC + 128 * MiB;
constexpr size_t OFF_Z = OFF_A;
constexpr size_t OFF_HDN = 510 * MiB;
constexpr size_t WS_NEED = 512 * MiB;
static_assert(OFF_GC + 2 * MiB <= 512 * MiB && OFF_Y + 64 * MiB <= OFF_W1 && OFF_ZT + 64 * MiB <= OFF_W1 && WS_NEED <= 512 * MiB, "workspace map");
constexpr int LDS_BYTES = 147456;

struct Params {
    const float *x, *c, *ctx, *c_ctx, *mod_w, *mod_b, *norm1_w, *norm2_w, *ab_w_in, *ab_conv_w, *gdn_a_log, *gdn_dt_bias, *gdn_norm_w, *gla_gate_w, *gla_gate_b, *gla_norm_w, *ab_w_out,
        *hy_w_in, *hy_conv_w, *hy_pos_w1, *hy_pos_b1, *hy_pos_w2, *hy_pos_b2, *hy_pos_w3, *hy_pos_b3, *hy_freq, *hy_filt_out, *hy_skip, *hy_w_out, *ffn_w1, *ffn_w3, *ffn_w2, *final_norm_w;
    float* out; unsigned char* ws;
};

DI void conv_unit(bf16_t* dst, int K, int mode, const float* src, const float* src2, int ld, int rt, int kt) {
    int tid_ = threadIdx.x; asm volatile("" : "+v"(tid_)); const int tid = tid_, l = tid & 63, kq = tid >> 6, R = rt * 64 + l, k = kt * 64 + kq * 8;
    int col = R; const float* s = src;
    if (mode == 1) { col = R < 2048 ? R : (R < 3584 ? R + 16 : (R < 3600 ? 2048 + (R - 3584) : (R < 3632 ? R : -1))); }
    else if (mode == 2) { col = 128 * (R >> 8) + 64 * ((R >> 7) & 1) + 16 * ((R >> 5) & 3) + (R & 15); if ((R >> 4) & 1) s = src2; }
    float v[8];
#pragma unroll
    for (int i = 0; i < 8; ++i) v[i] = col >= 0 ? s[(size_t)(k + i) * ld + col] : 0.f;
    u32x4 w; w.x = cvt_pk_bf16(v[0], v[1]); w.y = cvt_pk_bf16(v[2], v[3]); w.z = cvt_pk_bf16(v[4], v[5]); w.w = cvt_pk_bf16(v[6], v[7]);
    *(u32x4*)(dst + (size_t)R * K + k) = w;
}
DI int conv_job(int base, bf16_t* dst, int K, int nrows, int mode, const float* src, const float* src2, int ld) {
    const int nrt = nrows / 64, nu = nrt * (K / 64);
    int g0 = (int)blockIdx.x - (base % (int)gridDim.x); if (g0 < 0) g0 += gridDim.x;
    for (int uu = g0; uu < nu; uu += gridDim.x) conv_unit(dst, K, mode, src, src2, ld, uu % nrt, uu / nrt);
    return base + nu;
}
DI void modvec_item(const Params& p, int item, float* lds) {
    int tid_ = threadIdx.x; asm volatile("" : "+v"(tid_)); const int tid = tid_, layer = item / 96, cg0 = (item % 96) * 64, c4 = (tid & 15) * 4, ks = tid >> 4;
    const float* W = p.mod_w + (size_t)layer * 1024 * 6144;
    f32x4 acc[5];
#pragma unroll
    for (int r = 0; r < 5; ++r) acc[r] = (f32x4){0.f, 0.f, 0.f, 0.f};
    for (int kk = 0; kk < 32; ++kk) { const int k = ks * 32 + kk; const f32x4 w = *(const f32x4*)(W + (size_t)k * 6144 + cg0 + c4);
#pragma unroll
        for (int r = 0; r < 5; ++r) { const float cv = r < 4 ? p.c[r * 1024 + k] : p.c_ctx[k]; acc[r] += w * siluf(cv); } }
#pragma unroll
    for (int r = 0; r < 5; ++r) *(f32x4*)(lds + ((ks * 5 + r) * 64 + c4)) = acc[r];
    __syncthreads();
    if (tid < 320) { const int r = tid >> 6, cc = tid & 63; float s = 0.f; for (int q = 0; q < 32; ++q) s += lds[(q * 5 + r) * 64 + cc];
        ((float*)(p.ws + OFF_MODV))[(size_t)(layer * 5 + r) * 6144 + cg0 + cc] = s + p.mod_b[layer * 6144 + cg0 + cc]; }
    __syncthreads();
}
DI void norm_phase(const float* lat, const float* ctxp, bf16_t* dst, int nrows, const float* gain, const float* modv, int sh_off, int sc_off) {
    const int lane = threadIdx.x & 63, wid = threadIdx.x >> 6;
    for (int r = blockIdx.x * 8 + wid; r < nrows; r += gridDim.x * 8) {
        const float* s = r < T_LAT ? lat + (size_t)r * DM : ctxp + (size_t)(r - T_LAT) * DM; const int mrow = r < T_LAT ? (r >> 13) : 4;
        f32x4 v[4]; float ss = 0.f;
#pragma unroll
        for (int i = 0; i < 4; ++i) { v[i] = __builtin_nontemporal_load((const f32x4*)(s + i * 256 + lane * 4)); ss += v[i][0] * v[i][0] + v[i][1] * v[i][1] + v[i][2] * v[i][2] + v[i][3] * v[i][3]; }
#pragma unroll
        for (int o = 32; o > 0; o >>= 1) ss += __shfl_xor(ss, o);
        const float rstd = rsqrtf(ss * (1.f / DM) + 1e-6f); const float* mv = modv + (size_t)mrow * 6144;
#pragma unroll
        for (int i = 0; i < 4; ++i) { const int col = i * 256 + lane * 4; const f32x4 g = *(const f32x4*)(gain + col), sh = *(const f32x4*)(mv + sh_off + col), sc = *(const f32x4*)(mv + sc_off + col);
            const f32x4 y = v[i] * rstd * g * (sc + 1.f) + sh; u32x2 w; w.x = cvt_pk_bf16(y[0], y[1]); w.y = cvt_pk_bf16(y[2], y[3]); *(u32x2*)(dst + (size_t)r * DM + col) = w; }
    }
}
DI void final_norm_phase(float* h, const float* gain) {
    const int lane = threadIdx.x & 63, wid = threadIdx.x >> 6;
    for (int r = blockIdx.x * 8 + wid; r < T_LAT; r += gridDim.x * 8) { float* s = h + (size_t)r * DM; f32x4 v[4]; float ss = 0.f;
#pragma unroll
        for (int i = 0; i < 4; ++i) { v[i] = __builtin_nontemporal_load((const f32x4*)(s + i * 256 + lane * 4)); ss += v[i][0] * v[i][0] + v[i][1] * v[i][1] + v[i][2] * v[i][2] + v[i][3] * v[i][3]; }
#pragma unroll
        for (int o = 32; o > 0; o >>= 1) ss += __shfl_xor(ss, o);
        const float rstd = rsqrtf(ss * (1.f / DM) + 1e-6f);
#pragma unroll
        for (int i = 0; i < 4; ++i) { const int col = i * 256 + lane * 4; __builtin_nontemporal_store(v[i] * rstd * *(const f32x4*)(gain + col), (f32x4*)(s + col)); } }
}
DI void copy_f32_phase(float* dst, const float* src, size_t n4) {
    for (size_t i = (size_t)blockIdx.x * blockDim.x + threadIdx.x; i < n4; i += (size_t)gridDim.x * blockDim.x) ((f32x4*)dst)[i] = ((const f32x4*)src)[i];
}
template <class Epi> DI void run_gemm(unsigned char* smem, const bf16_t* A, const bf16_t* Bt, int M, int N, int K, const Epi& E) {
    pg8::Gemm g{A, Bt, M, N, K}; pg8::StaticOrder S; S.init(M, N, gridDim.x, blockIdx.x);
    pg8::gemm_phase<Epi, pg8::StaticOrder, true, true>((PG8_LAS unsigned char*)smem, g, S, E);
}

#define XB_TMO      128
#define XB_XCNT(j)  (256  + 64 * (j))
#define XB_XSUB(j)  (1280 + 64 * (j))
#define XB_XGEN(j)  (2304 + 64 * (j))
#define XB_TOP      3328
#define XB_TOPGEN   3392
#define XCD_BAR_WORDS 3456
#define XB_SPIN_CAP (1u << 18)
#define LAS __attribute__((address_space(3)))

__device__ __forceinline__ unsigned xb_ld(unsigned* p)              { return __hip_atomic_load(p, __ATOMIC_RELAXED, __HIP_MEMORY_SCOPE_AGENT); }
__device__ __forceinline__ unsigned xb_add(unsigned* p, unsigned v) { return __hip_atomic_fetch_add(p, v, __ATOMIC_RELAXED, __HIP_MEMORY_SCOPE_AGENT); }
__device__ __forceinline__ unsigned xb_xcc_id() { return (unsigned)__builtin_amdgcn_s_getreg((3 << 11) | 20) & 0xFu; }
#define XB_SPIN(cond, bar) do { unsigned _sp = 0; while (cond) { __builtin_amdgcn_s_sleep(1); \
    if ((++_sp & 255u) == 0u) { if (xb_ld(&(bar)[XB_TMO])) break; if (_sp > XB_SPIN_CAP) { atomicAdd(&(bar)[XB_TMO], 1u); break; } } } } while (0)

struct XcdBarrier {
    unsigned* bar; unsigned x;
    volatile LAS unsigned* st;
};

__device__ __forceinline__ XcdBarrier xcd_barrier_post(unsigned* bar, volatile LAS unsigned* st) {
    XcdBarrier b; b.bar = bar; b.x = xb_xcc_id(); b.st = st;
    if (threadIdx.x == 0) (void)xb_add(&bar[XB_XCNT(b.x)], 1u);
    return b;
}
__device__ __forceinline__ void xcd_barrier_complete(unsigned* bar, unsigned x, unsigned& nloc, unsigned& nx) {
    const unsigned G = gridDim.x * gridDim.y * gridDim.z;
    unsigned sum, cnt, mine, sp = 0u;
    for (;;) {
        sum = 0u; cnt = 0u; mine = 0u;
#pragma unroll
        for (unsigned j = 0; j < 16; ++j) { const unsigned c = xb_ld(&bar[XB_XCNT(j)]); sum += c; cnt += (c > 0u) ? 1u : 0u; mine = (j == x) ? c : mine; }
        if (sum == G) break;
        __builtin_amdgcn_s_sleep(1);
        if ((++sp & 255u) == 0u) { if (xb_ld(&bar[XB_TMO])) break; if (sp > XB_SPIN_CAP) { atomicAdd(&bar[XB_TMO], 1u); break; } }
    }
    nloc = mine > 0u ? mine : 1u; nx = cnt > 0u ? cnt : 1u;
}

__device__ __forceinline__ void xcd_barrier(const XcdBarrier& b) {
    asm volatile("s_waitcnt vmcnt(0)" ::: "memory");
    __syncthreads();
    if (threadIdx.x == 0) {
        unsigned* bar = b.bar;
        __builtin_amdgcn_s_waitcnt(0);
        unsigned nloc = b.st[0], nx = b.st[1];
        if (nloc == 0u) { xcd_barrier_complete(bar, b.x, nloc, nx); b.st[0] = nloc; b.st[1] = nx; }
        const unsigned old = xb_add(&bar[XB_XSUB(b.x)], 1u);
        const unsigned gen = old / nloc;
        if (old + 1u == (gen + 1u) * nloc) {
            __builtin_amdgcn_fence(__ATOMIC_RELEASE, "agent");
            asm volatile("s_waitcnt vmcnt(0)" ::: "memory");
            const unsigned og = xb_add(&bar[XB_TOP], 1u);
            const unsigned tg = og / nx;
            if (og + 1u == (tg + 1u) * nx) xb_add(&bar[XB_TOPGEN], 1u);
            else XB_SPIN(xb_ld(&bar[XB_TOPGEN]) == tg, bar);
            __builtin_amdgcn_fence(__ATOMIC_ACQUIRE, "agent");
            xb_add(&bar[XB_XGEN(b.x)], 1u);
            asm volatile("s_waitcnt vmcnt(0)" ::: "memory");
        } else {
            XB_SPIN(xb_ld(&bar[XB_XGEN(b.x)]) == gen, bar);
            __builtin_amdgcn_fence(__ATOMIC_ACQUIRE, "agent");
            asm volatile("s_waitcnt vmcnt(0)" ::: "memory");
        }
    }
    __syncthreads();
}


constexpr size_t OFF_BAR = 245760;
constexpr int LDS_XB_ST = LDS_BYTES - 16;
DI f32x4 mfma16(bf16x8 a, bf16x8 b, f32x4 c) { return __builtin_amdgcn_mfma_f32_16x16x32_bf16(a, b, c, 0, 0, 0); }
DI bf16x8 ldsfrag(const unsigned char* base, int byteoff) { return *(const bf16x8*)(base + byteoff); }
DI size_t chunk_row0(int b, int j) { return j < 4 ? (size_t)T_LAT + b * 256 + j * 64 : (size_t)b * SEQ + (size_t)(j - 4) * 64; }
DI float softplusf_(float x) { return x > 20.f ? x : log1pf(__expf(x)); }
constexpr f32x4 Z4 = {0.f, 0.f, 0.f, 0.f};
DI void lds_barrier() { asm volatile("s_waitcnt lgkmcnt(0)" ::: "memory"); __builtin_amdgcn_s_barrier(); asm volatile("" ::: "memory"); }

constexpr int GP_Q = 0, GP_K = 17408, GP_KT = 34816, GP_VT = 53248, GP_X = 71680, GP_N = 108544, GP_GC = 141312;
DI void gdn_prep_item(const Params& p, unsigned char* smem, int item) {
    int tid_ = threadIdx.x; asm volatile("" : "+v"(tid_)); const int tid = tid_, lane = tid & 63, wid = tid >> 6, fr = lane & 15, fq = lane >> 4;
    const int h = item & 3, j = (item >> 2) % 132, b = item / 528;
    const size_t row0 = chunk_row0(b, j);
    unsigned char* ws = p.ws;
    const bf16_t* R = (const bf16_t*)(ws + OFF_R); const float* G = (const float*)(ws + OFF_G);
    bf16_t* QH = (bf16_t*)p.out + (size_t)item * 8192; bf16_t* KT = (bf16_t*)p.out + (size_t)2112 * 8192 + (size_t)item * 8192;
    float* gc_s = (float*)(smem + GP_GC); float* beta_s = gc_s + 128;
    { const int c = tid >> 3, g8 = tid & 7, col0 = g8 * 16;
      const bool hasp = !(c == 0 && (j == 0 || j == 4)), hasn = !(c == 63 && (j == 3 || j == 131));
#pragma unroll
      for (int t = 0; t < 3; ++t) {
          const int gc0 = t * 512 + h * 128 + col0; const bf16_t* rp = R + (row0 + c) * 1536 + gc0;
          u32x4 xm[2], x0[2], xp[2];
#pragma unroll
          for (int q = 0; q < 2; ++q) { x0[q] = *(const u32x4*)(rp + q * 8); xm[q] = hasp ? *(const u32x4*)(rp - 1536 + q * 8) : (u32x4){0u, 0u, 0u, 0u}; xp[q] = hasn ? *(const u32x4*)(rp + 1536 + q * 8) : (u32x4){0u, 0u, 0u, 0u}; }
          f32x4 wv[3][4];
#pragma unroll
          for (int jj = 0; jj < 3; ++jj)
#pragma unroll
              for (int k4 = 0; k4 < 4; ++k4) wv[jj][k4] = *(const f32x4*)(p.ab_conv_w + jj * 1536 + gc0 + 4 * k4);
          float o[16]; float ss = 0.f;
#pragma unroll
          for (int q = 0; q < 2; ++q)
#pragma unroll
              for (int e = 0; e < 4; ++e) { const int ci = q * 8 + e * 2;
                  float a0 = wv[0][ci >> 2][ci & 3] * bflo(xm[q][e]) + wv[1][ci >> 2][ci & 3] * bflo(x0[q][e]) + wv[2][ci >> 2][ci & 3] * bflo(xp[q][e]);
                  float a1 = wv[0][ci >> 2][(ci & 3) + 1] * bfhi(xm[q][e]) + wv[1][ci >> 2][(ci & 3) + 1] * bfhi(x0[q][e]) + wv[2][ci >> 2][(ci & 3) + 1] * bfhi(xp[q][e]);
                  a0 = siluf(a0); a1 = siluf(a1); o[ci] = a0; o[ci + 1] = a1; ss += a0 * a0 + a1 * a1; }
          if (t < 2) { ss += __shfl_xor(ss, 1); ss += __shfl_xor(ss, 2); ss += __shfl_xor(ss, 4); const float sc = rsqrtf(ss + 1e-6f) * (t == 0 ? 0.08838834764831845f : 1.f);
#pragma unroll
              for (int e = 0; e < 16; ++e) o[e] *= sc; }
          u32x4 w0, w1; w0.x = cvt_pk_bf16(o[0], o[1]); w0.y = cvt_pk_bf16(o[2], o[3]); w0.z = cvt_pk_bf16(o[4], o[5]); w0.w = cvt_pk_bf16(o[6], o[7]);
          w1.x = cvt_pk_bf16(o[8], o[9]); w1.y = cvt_pk_bf16(o[10], o[11]); w1.z = cvt_pk_bf16(o[12], o[13]); w1.w = cvt_pk_bf16(o[14], o[15]);
          if (t == 0) { *(u32x4*)(smem + GP_Q + c * 272 + col0 * 2) = w0; *(u32x4*)(smem + GP_Q + c * 272 + col0 * 2 + 16) = w1; *(u32x4*)(QH + c * 128 + col0) = w0; *(u32x4*)(QH + c * 128 + col0 + 8) = w1; }
          else if (t == 1) { *(u32x4*)(smem + GP_K + c * 272 + col0 * 2) = w0; *(u32x4*)(smem + GP_K + c * 272 + col0 * 2 + 16) = w1;
#pragma unroll
              for (int e = 0; e < 16; ++e) *(bf16_t*)(smem + GP_KT + (col0 + e) * 144 + c * 2) = f2bf(o[e]); }
          else {
#pragma unroll
              for (int e = 0; e < 16; ++e) *(bf16_t*)(smem + GP_VT + (col0 + e) * 144 + c * 2) = f2bf(o[e]); }
      }
      if (tid < 128) { const int dir = tid >> 6, cc = tid & 63; const float* gr = G + (row0 + cc) * 64;
          float g = -__expf(p.gdn_a_log[dir * 4 + h]) * softplusf_(gr[dir * 4 + h] + p.gdn_dt_bias[dir * 4 + h]); const float be = sigmoidf_(gr[8 + dir * 4 + h]);
          if (dir == 0) {
#pragma unroll
              for (int o = 1; o < 64; o <<= 1) { const float t = __shfl_up(g, o); if (lane >= o) g += t; } }
          else {
#pragma unroll
              for (int o = 1; o < 64; o <<= 1) { const float t = __shfl_down(g, o); if (lane + o < 64) g += t; } }
          gc_s[dir * 64 + cc] = g; beta_s[dir * 64 + cc] = be;
          ((float*)(ws + OFF_GC))[((size_t)item * 2 + dir) * 64 + cc] = g; }
    }
    __syncthreads();
    { float* kk_s = (float*)(smem + GP_X); float* qk_s = kk_s + 4096;
#pragma unroll
      for (int tt = 0; tt < 2; ++tt) { const int tile = wid * 2 + tt, mt = tile >> 2, nt = tile & 3; f32x4 ak = Z4, aq = Z4;
#pragma unroll
          for (int ks = 0; ks < 4; ++ks) { const int co = (32 * ks + 8 * fq) * 2; const bf16x8 bk = ldsfrag(smem, GP_K + (16 * nt + fr) * 272 + co);
              ak = mfma16(ldsfrag(smem, GP_K + (16 * mt + fr) * 272 + co), bk, ak); aq = mfma16(ldsfrag(smem, GP_Q + (16 * mt + fr) * 272 + co), bk, aq); }
#pragma unroll
          for (int r = 0; r < 4; ++r) { kk_s[(16 * mt + 4 * fq + r) * 64 + 16 * nt + fr] = ak[r]; qk_s[(16 * mt + 4 * fq + r) * 64 + 16 * nt + fr] = aq[r]; } }
      const int d = tid >> 2, part = tid & 3;
      *(u32x4*)(KT + d * 64 + part * 16) = *(const u32x4*)(smem + GP_KT + d * 144 + part * 32); *(u32x4*)(KT + d * 64 + part * 16 + 8) = *(const u32x4*)(smem + GP_KT + d * 144 + part * 32 + 16);
    }
    __syncthreads();
    { const float* kk_s = (const float*)(smem + GP_X); const float* qk_s = kk_s + 4096; float* N_s = (float*)(smem + GP_N);
#pragma unroll
      for (int q = 0; q < 2; ++q) { const int pc = tid + 512 * q, dir = pc >> 9, ip = (pc >> 3) & 63, g8 = pc & 7, i = dir ? 63 - ip : ip, base = dir ? 56 - 8 * g8 : 8 * g8;
          const f32x4 k0 = *(const f32x4*)(kk_s + i * 64 + base), k1 = *(const f32x4*)(kk_s + i * 64 + base + 4), c0 = *(const f32x4*)(gc_s + dir * 64 + base), c1 = *(const f32x4*)(gc_s + dir * 64 + base + 4);
          const float bi = beta_s[dir * 64 + i], gi = gc_s[dir * 64 + i]; float v[8];
#pragma unroll
          for (int e = 0; e < 8; ++e) { const int se = dir ? 7 - e : e; const float kv = se < 4 ? k0[se & 3] : k1[se & 3], cv = se < 4 ? c0[se & 3] : c1[se & 3]; v[e] = (8 * g8 + e) < ip ? bi * kv * __expf(gi - cv) : 0.f; }
          *(f32x4*)(N_s + dir * 4096 + ip * 64 + 8 * g8) = (f32x4){v[0], v[1], v[2], v[3]}; *(f32x4*)(N_s + dir * 4096 + ip * 64 + 8 * g8 + 4) = (f32x4){v[4], v[5], v[6], v[7]}; }
#pragma unroll
      for (int q = 0; q < 2; ++q) { const int pc = tid + 512 * q, dir = pc >> 9, i = (pc >> 3) & 63, j8 = pc & 7; float v[8];
#pragma unroll
          for (int e = 0; e < 8; ++e) { const int jj = j8 * 8 + e; const bool keep = dir ? (jj >= i) : (jj <= i); v[e] = keep ? qk_s[i * 64 + jj] * __expf(gc_s[dir * 64 + i] - gc_s[dir * 64 + jj]) : 0.f; }
          u32x4 w; w.x = cvt_pk_bf16(v[0], v[1]); w.y = cvt_pk_bf16(v[2], v[3]); w.z = cvt_pk_bf16(v[4], v[5]); w.w = cvt_pk_bf16(v[6], v[7]);
          *(u32x4*)((bf16_t*)(ws + OFF_ATT) + ((size_t)item * 2 + dir) * 4096 + i * 64 + j8 * 8) = w; }
    }
    __syncthreads();
    { const int SCR = GP_Q; float Tc[32];
      if (wid < 4) { const int dir = wid >> 1, blkB = wid & 1; const int r0 = blkB * 32, jl = lane & 31;
          const float* Nb = (const float*)(smem + GP_N) + dir * 4096 + r0 * 65;
          const int jp = r0 + jl, jo = dir ? 63 - jp : jp; const float bj = beta_s[dir * 64 + jo], bej = bj * __expf(gc_s[dir * 64 + jo]);
          const int st = dir ? -72 : 72;
          bf16_t* p1 = (bf16_t*)(smem + GP_X) + dir * 4608 + (dir ? 63 - r0 : r0) * 72 + jo; bf16_t* p2 = p1 + 9216;
          bf16_t* z1 = (bf16_t*)(smem + GP_X) + dir * 4608 + (dir ? 63 : 0) * 72 + jo;
          bf16_t* tp = (bf16_t*)(smem + SCR + dir * 10240 + (blkB ? 5120 + jl * 2 : jl * 80));
          const int tps = blkB ? 40 : 1;
#pragma unroll
          for (int il = 0; il < 32; ++il) { float a = (jl == il) ? 1.f : 0.f;
#pragma unroll
              for (int kl = 0; kl < il; ++kl) a -= Nb[il * 64 + kl] * Tc[kl];
              Tc[il] = a;
              p1[0] = f2bf(a * bj); p2[0] = f2bf(a * bej); tp[0] = f2bf(a);
              if (blkB) { z1[0] = 0; z1[9216] = 0; }
              p1 += st; p2 += st; z1 += st; tp += tps; asm volatile("" ::: "memory"); } }
      else {
          const int t2 = tid - 256;
#pragma unroll
          for (int q = 0; q < 8; ++q) { const int e2 = t2 + 256 * q, dir = e2 >> 10, il = (e2 >> 5) & 31, kl = e2 & 31;
              *(bf16_t*)(smem + SCR + dir * 10240 + 2560 + il * 80 + kl * 2) = f2bf(((const float*)(smem + GP_N))[dir * 4096 + (32 + il) * 64 + kl]); } }
    }
    __syncthreads();
    if (wid < 2) { const int dir = wid; const int SCR = GP_Q + dir * 10240;
        f32x4 x[2][2];
#pragma unroll
        for (int mt = 0; mt < 2; ++mt)
#pragma unroll
            for (int nt = 0; nt < 2; ++nt) x[mt][nt] = mfma16(ldsfrag(smem, SCR + 2560 + (16 * mt + fr) * 80 + fq * 16), ldsfrag(smem, SCR + (16 * nt + fr) * 80 + fq * 16), Z4);
#pragma unroll
        for (int mt = 0; mt < 2; ++mt)
#pragma unroll
            for (int nt = 0; nt < 2; ++nt) { u32x2 w; w.x = cvt_pk_bf16(x[mt][nt][0], x[mt][nt][1]); w.y = cvt_pk_bf16(x[mt][nt][2], x[mt][nt][3]); *(u32x2*)(smem + SCR + 7680 + (16 * nt + fr) * 80 + (16 * mt + 4 * fq) * 2) = w; }
        bf16_t* A1 = (bf16_t*)(smem + GP_X) + dir * 4608; bf16_t* A2 = (bf16_t*)(smem + GP_X + 18432) + dir * 4608;
#pragma unroll
        for (int mt = 0; mt < 2; ++mt)
#pragma unroll
            for (int nt = 0; nt < 2; ++nt) { const f32x4 t = mfma16(ldsfrag(smem, SCR + 5120 + (16 * mt + fr) * 80 + fq * 16), ldsfrag(smem, SCR + 7680 + (16 * nt + fr) * 80 + fq * 16), Z4);
                const int jp = 16 * nt + fr, jo = dir ? 63 - jp : jp; const float bj = beta_s[dir * 64 + jo], bej = bj * __expf(gc_s[dir * 64 + jo]);
#pragma unroll
                for (int r = 0; r < 4; ++r) { const int ip = 32 + 16 * mt + 4 * fq + r, io = dir ? 63 - ip : ip; A1[io * 72 + jo] = f2bf(-t[r] * bj); A2[io * 72 + jo] = f2bf(-t[r] * bej); } }
    }
    __syncthreads();
    { const int dir = wid >> 2; const size_t pd = (size_t)item * 2 + dir; bf16_t* U0T = (bf16_t*)(ws + OFF_U0T) + pd * 8192; bf16_t* KCD = (bf16_t*)(ws + OFF_KCD) + pd * 8192;
      const int A1o = GP_X + dir * 9216, A2o = GP_X + 18432 + dir * 9216;
#pragma unroll
      for (int tt = 0; tt < 8; ++tt) { const int tile = (wid & 3) * 8 + tt; f32x4 au = Z4, ak = Z4;
          { const int mt = tile >> 3, nt = tile & 7;
#pragma unroll
            for (int ks = 0; ks < 2; ++ks) { const int co = (32 * ks + 8 * fq) * 2; au = mfma16(ldsfrag(smem, A1o + (16 * mt + fr) * 144 + co), ldsfrag(smem, GP_VT + (16 * nt + fr) * 144 + co), au); }
            u32x2 w; w.x = cvt_pk_bf16(au[0], au[1]); w.y = cvt_pk_bf16(au[2], au[3]); *(u32x2*)(U0T + (16 * nt + fr) * 64 + 16 * mt + 4 * fq) = w; }
          { const int md = tile >> 2, ni = tile & 3;
#pragma unroll
            for (int ks = 0; ks < 2; ++ks) { const int co = (32 * ks + 8 * fq) * 2; ak = mfma16(ldsfrag(smem, GP_KT + (16 * md + fr) * 144 + co), ldsfrag(smem, A2o + (16 * ni + fr) * 144 + co), ak); }
            u32x2 w; w.x = cvt_pk_bf16(ak[0], ak[1]); w.y = cvt_pk_bf16(ak[2], ak[3]); *(u32x2*)(KCD + (16 * ni + fr) * 128 + 16 * md + 4 * fq) = w; } }
    }
    __syncthreads();
}
constexpr int GS_KCD = 0, GS_QD = 17408, GS_KDT = 34816, GS_ATT = 53248, GS_ST = 62464, GS_UT = 97280;
DI void gdn_scan_chain(const Params& p, unsigned char* smem, int cid, int half) {
    const int tid = threadIdx.x, lane = tid & 63, wid = tid >> 6, fr = lane & 15, fq = lane >> 4;
    const int b = cid >> 3, h = (cid >> 1) & 3, dir = cid & 1;
    unsigned char* ws = p.ws;
    const bf16_t* QHg = (const bf16_t*)p.out; const bf16_t* KTg = (const bf16_t*)p.out + (size_t)2112 * 8192;
    bf16_t* OG = (bf16_t*)(ws + OFF_OGDN) + (size_t)dir * T_LAT * 512;
    const int cw = wid & 1, ecol0 = half * 32 + 16 * cw;
    const int STo = GS_ST + cw * 4352, UTo = GS_UT + cw * 2304;
    f32x4 S[8];
#pragma unroll
    for (int i = 0; i < 8; ++i) S[i] = Z4;
    if (wid < 2) for (int i = lane; i < 4352 / 16; i += 64) *(u32x4*)(smem + STo + i * 16) = (u32x4){0u, 0u, 0u, 0u};
    struct Pf { u32x4 rk[2], rq[2], rt[2], ra; u32x2 ru[4]; float gq[2]; f32x4 gk[2][2]; float gend; };
    Pf pfA, pfB;
#define GDN_PREFETCH(PF, jn) do { const int item_ = (b * 132 + (jn)) * 4 + h; const size_t pd_ = (size_t)item_ * 2 + dir; \
        const bf16_t* kcd_ = (const bf16_t*)(ws + OFF_KCD) + pd_ * 8192; const bf16_t* att_ = (const bf16_t*)(ws + OFF_ATT) + pd_ * 4096; const bf16_t* u0_ = (const bf16_t*)(ws + OFF_U0T) + pd_ * 8192; \
        const float* gc_ = (const float*)(ws + OFF_GC) + pd_ * 64; const bf16_t* qh_ = QHg + (size_t)item_ * 8192; const bf16_t* kt_ = KTg + (size_t)item_ * 8192; \
        _Pragma("unroll") for (int q_ = 0; q_ < 2; ++q_) { const int pid_ = tid + 512 * q_; (PF).rk[q_] = *(const u32x4*)(kcd_ + (pid_ >> 4) * 128 + (pid_ & 15) * 8); (PF).rq[q_] = *(const u32x4*)(qh_ + (pid_ >> 4) * 128 + (pid_ & 15) * 8); (PF).gq[q_] = gc_[pid_ >> 4]; \
            (PF).rt[q_] = *(const u32x4*)(kt_ + (pid_ >> 3) * 64 + (pid_ & 7) * 8); (PF).gk[q_][0] = *(const f32x4*)(gc_ + (pid_ & 7) * 8); (PF).gk[q_][1] = *(const f32x4*)(gc_ + (pid_ & 7) * 8 + 4); } \
        (PF).ra = *(const u32x4*)(att_ + (tid >> 3) * 64 + (tid & 7) * 8); (PF).gend = gc_[dir ? 0 : 63]; \
        _Pragma("unroll") for (int mt_ = 0; mt_ < 4; ++mt_) (PF).ru[mt_] = *(const u32x2*)(u0_ + (ecol0 + fr) * 64 + 16 * mt_ + 4 * fq); } while (0)
    GDN_PREFETCH(pfA, dir ? 3 : 0); GDN_PREFETCH(pfB, dir ? 2 : 1);
    unsigned pfv = 0u, pfacc = 0u;
#define GDN_WARM(jn) do { const int item_ = (b * 132 + (jn)) * 4 + h; const size_t pd_ = (size_t)item_ * 2 + dir; const bf16_t* a_; \
        if (tid < 128) a_ = (const bf16_t*)(ws + OFF_KCD) + pd_ * 8192 + tid * 64; else if (tid < 256) a_ = QHg + (size_t)item_ * 8192 + (tid - 128) * 64; \
        else if (tid < 384) a_ = KTg + (size_t)item_ * 8192 + (tid - 256) * 64; else if (tid < 448) a_ = (const bf16_t*)(ws + OFF_ATT) + pd_ * 4096 + (tid - 384) * 64; \
        else a_ = (const bf16_t*)(ws + OFF_U0T) + pd_ * 8192 + half * 4096 + (tid - 448) * 64; \
        pfv = *(const unsigned*)a_; } while (0)
    auto step = [&](Pf& pf, const int s) __attribute__((always_inline)) {
        const int j = dir ? (s < 4 ? 3 - s : 135 - s) : s;
        const float gl = __expf(pf.gend);
#pragma unroll
        for (int q = 0; q < 2; ++q) { const int pid = tid + 512 * q;
            *(u32x4*)(smem + GS_KCD + (pid >> 4) * 272 + (pid & 15) * 16) = pf.rk[q];
            { const float sc = __expf(pf.gq[q]); u32x4 w;
#pragma unroll
              for (int e = 0; e < 4; ++e) w[e] = cvt_pk_bf16(bflo(pf.rq[q][e]) * sc, bfhi(pf.rq[q][e]) * sc);
              *(u32x4*)(smem + GS_QD + (pid >> 4) * 272 + (pid & 15) * 16) = w; }
            { u32x4 w;
#pragma unroll
              for (int e = 0; e < 4; ++e) { const float s0 = __expf(pf.gend - pf.gk[q][e >> 1][(e & 1) * 2]), s1 = __expf(pf.gend - pf.gk[q][e >> 1][(e & 1) * 2 + 1]); w[e] = cvt_pk_bf16(bflo(pf.rt[q][e]) * s0, bfhi(pf.rt[q][e]) * s1); }
              *(u32x4*)(smem + GS_KDT + (pid >> 3) * 144 + (pid & 7) * 16) = w; } }
        *(u32x4*)(smem + GS_ATT + (tid >> 3) * 144 + (tid & 7) * 16) = pf.ra;
        f32x4 u[4];
#pragma unroll
        for (int mt = 0; mt < 4; ++mt) u[mt] = (f32x4){bflo(pf.ru[mt].x), bfhi(pf.ru[mt].x), bflo(pf.ru[mt].y), bfhi(pf.ru[mt].y)};
        lds_barrier();
        if (s + 2 < 132) { const int jn = dir ? (s + 2 < 4 ? 3 - (s + 2) : 135 - (s + 2)) : s + 2; GDN_PREFETCH(pf, jn); }
        if (wid < 2) {
        __builtin_amdgcn_s_setprio(2);
        bf16x8 sb[4];
#pragma unroll
        for (int ks = 0; ks < 4; ++ks) sb[ks] = ldsfrag(smem, STo + fr * 272 + (32 * ks + 8 * fq) * 2);
#pragma unroll
        for (int mt = 0; mt < 4; ++mt) { f32x4 pacc = Z4;
#pragma unroll
            for (int ks = 0; ks < 4; ++ks) pacc = mfma16(ldsfrag(smem, GS_KCD + (16 * mt + fr) * 272 + (32 * ks + 8 * fq) * 2), sb[ks], pacc);
            u[mt] -= pacc;
            u32x2 w; w.x = cvt_pk_bf16(u[mt][0], u[mt][1]); w.y = cvt_pk_bf16(u[mt][2], u[mt][3]); *(u32x2*)(smem + UTo + fr * 144 + (16 * mt + 4 * fq) * 2) = w; }
        bf16x8 ub[2];
#pragma unroll
        for (int ks = 0; ks < 2; ++ks) ub[ks] = ldsfrag(smem, UTo + fr * 144 + (32 * ks + 8 * fq) * 2);
        if (j >= 4) { const size_t row0 = (size_t)b * SEQ + (size_t)(j - 4) * 64;
#pragma unroll
            for (int mt = 0; mt < 4; ++mt) { f32x4 o = Z4;
#pragma unroll
                for (int ks = 0; ks < 4; ++ks) o = mfma16(ldsfrag(smem, GS_QD + (16 * mt + fr) * 272 + (32 * ks + 8 * fq) * 2), sb[ks], o);
#pragma unroll
                for (int ks = 0; ks < 2; ++ks) o = mfma16(ldsfrag(smem, GS_ATT + (16 * mt + fr) * 144 + (32 * ks + 8 * fq) * 2), ub[ks], o);
#pragma unroll
                for (int r = 0; r < 4; ++r) OG[(row0 + 16 * mt + 4 * fq + r) * 512 + h * 128 + ecol0 + fr] = f2bf(o[r]); } }
#pragma unroll
        for (int md = 0; md < 8; ++md) { f32x4 a = S[md] * gl;
#pragma unroll
            for (int ks = 0; ks < 2; ++ks) a = mfma16(ldsfrag(smem, GS_KDT + (16 * md + fr) * 144 + (32 * ks + 8 * fq) * 2), ub[ks], a);
            S[md] = a;
            u32x2 w; w.x = cvt_pk_bf16(a[0], a[1]); w.y = cvt_pk_bf16(a[2], a[3]); *(u32x2*)(smem + STo + fr * 272 + (16 * md + 4 * fq) * 2) = w; }
        __builtin_amdgcn_s_setprio(0);
        }
        lds_barrier();
    };
    for (int s2 = 0; s2 < 132; s2 += 2) { step(pfA, s2); step(pfB, s2 + 1); }
#undef GDN_PREFETCH
#undef GDN_WARM
    asm volatile("" :: "v"(pfacc));
}
constexpr size_t OFF_GKDT = OFF_A + 128 * MiB;
constexpr size_t OFF_GGL = OFF_GC + 2 * MiB;
constexpr size_t DOUT_GQD = (size_t)2 * 2112 * 8192;
static_assert(OFF_GKDT + 33 * MiB <= OFF_P2 && OFF_GGL + 2 * MiB <= 512 * MiB, "gla map");
constexpr int GL_LLR = 0, GL_Q = 4096, GL_K = 13312, GL_QD = 22528, GL_QT = 31744, GL_KTL = 40960, GL_KDT = 50176, GL_VT = 59392, GL_ATT = 77824, GL_SEG = 87040, GL_END = 89088;
DI void gla_pre_phase(const Params& p, unsigned char* smem) {
    int tid_ = threadIdx.x; asm volatile("" : "+v"(tid_)); const int tid = tid_, lane = tid & 63, wid = tid >> 6, fr = lane & 15, fq = lane >> 4;
    unsigned char* ws = p.ws;
    const bf16_t* P2 = (const bf16_t*)(ws + OFF_P2); const float* G = (const float*)(ws + OFF_G);
    const int dcol = tid & 63, seg = tid >> 6;
    float gw[16]; float gbias = 0.f; int gcode = -1;
    u32x4 nq, nk, nv[2]; f32x4 nl = Z4;
#define GLAPRE_LOAD(it_) do { const int dir_ = (it_) & 1, h_ = ((it_) >> 1) & 3, j_ = ((it_) >> 3) % 132, b_ = (it_) / 1056; const size_t r0_ = chunk_row0(b_, j_); \
        const bf16_t* pr_ = P2 + (r0_ + (tid >> 3)) * 2048 + (tid & 7) * 8; nq = *(const u32x4*)(pr_ + 512 + h_ * 64); nk = *(const u32x4*)(pr_ + 768 + h_ * 64); \
        _Pragma("unroll") for (int q_ = 0; q_ < 2; ++q_) { const int pid_ = tid + 512 * q_; nv[q_] = *(const u32x4*)(P2 + (r0_ + (pid_ & 63)) * 2048 + 1024 + h_ * 128 + (pid_ >> 6) * 8); } \
        if (tid < 256) nl = *(const f32x4*)(G + (r0_ + (tid >> 2)) * 64 + 16 + dir_ * 16 + (tid & 3) * 4); } while (0)
    if ((int)blockIdx.x < 4224) GLAPRE_LOAD((int)blockIdx.x);
    for (int item = blockIdx.x; item < 4224; item += gridDim.x) {
    const int dir = item & 1, h = (item >> 1) & 3, j = (item >> 3) % 132, b = item / 1056;
    if ((item & 7) != gcode) { gcode = item & 7;
#pragma unroll
        for (int r = 0; r < 16; ++r) gw[r] = p.gla_gate_w[(dir * 16 + r) * 256 + h * 64 + dcol];
        gbias = p.gla_gate_b[dir * 256 + h * 64 + dcol]; }
    { *(u32x4*)(smem + GL_Q + (tid >> 3) * 144 + (tid & 7) * 16) = nq; *(u32x4*)(smem + GL_K + (tid >> 3) * 144 + (tid & 7) * 16) = nk;
#pragma unroll
      for (int q = 0; q < 2; ++q) { const int pid = tid + 512 * q, c = pid & 63, e0 = (pid >> 6) * 8;
#pragma unroll
          for (int e = 0; e < 4; ++e) { *(bf16_t*)(smem + GL_VT + (e0 + 2 * e) * 144 + c * 2) = (bf16_t)(nv[q][e] & 0xffffu); *(bf16_t*)(smem + GL_VT + (e0 + 2 * e + 1) * 144 + c * 2) = (bf16_t)(nv[q][e] >> 16); } }
      if (tid < 256) *(f32x4*)(smem + GL_LLR + (tid >> 2) * 64 + (tid & 3) * 16) = nl;
      if (item + (int)gridDim.x < 4224) GLAPRE_LOAD(item + (int)gridDim.x); }
    lds_barrier();
    float inc[8]; float tot8 = 0.f;
    { float la[8];
#pragma unroll
      for (int i = 0; i < 8; ++i) { const f32x4* lr = (const f32x4*)(smem + GL_LLR + (seg * 8 + i) * 64); float g = gbias;
#pragma unroll
          for (int r4 = 0; r4 < 4; ++r4) { const f32x4 l4 = lr[r4];
#pragma unroll
              for (int r = 0; r < 4; ++r) g += l4[r] * gw[r4 * 4 + r]; }
          la[i] = (fminf(g, 0.f) - log1pf(__expf(-fabsf(g)))) * (1.f / 16.f); }
      if (dir == 0) {
#pragma unroll
          for (int i = 0; i < 8; ++i) { tot8 += la[i]; inc[i] = tot8; } }
      else {
#pragma unroll
          for (int i = 7; i >= 0; --i) { tot8 += la[i]; inc[i] = tot8; } } }
    ((float*)(smem + GL_SEG))[seg * 64 + dcol] = tot8;
    lds_barrier();
    { float off = 0.f, tot = 0.f, ref = 0.f;
#pragma unroll
      for (int sg = 0; sg < 8; ++sg) { const float v = ((const float*)(smem + GL_SEG))[sg * 64 + dcol]; tot += v; if (dir == 0 ? sg < seg : sg > seg) off += v; if (dir == 0 ? sg < 4 : sg >= 4) ref += v; }
      u32x4 kdw;
#pragma unroll
      for (int i = 0; i < 8; i += 2) { float kdv[2];
#pragma unroll
          for (int ii = 0; ii < 2; ++ii) { const int c = seg * 8 + i + ii; const float bc = off + inc[i + ii];
              const float qv = bf2f(*(const bf16_t*)(smem + GL_Q + c * 144 + dcol * 2)) * 0.125f, kv = bf2f(*(const bf16_t*)(smem + GL_K + c * 144 + dcol * 2));
              *(bf16_t*)(smem + GL_QD + c * 144 + dcol * 2) = f2bf(qv * __expf(bc)); *(bf16_t*)(smem + GL_QT + c * 144 + dcol * 2) = f2bf(qv * __expf(bc - ref));
              *(bf16_t*)(smem + GL_KTL + c * 144 + dcol * 2) = f2bf(kv * __expf(ref - bc)); kdv[ii] = kv * __expf(tot - bc); }
          kdw[i >> 1] = cvt_pk_bf16(kdv[0], kdv[1]); }
      *(u32x4*)((bf16_t*)(ws + OFF_GKDT) + (size_t)item * 4096 + dcol * 64 + seg * 8) = kdw;
      if (seg == 0) ((float*)(ws + OFF_GGL))[(size_t)item * 64 + dcol] = __expf(tot); }
    lds_barrier();
    if (j >= 4) {
        { const int lit = ((b * 128 + (j - 4)) * 4 + h) * 2 + dir;
          *(u32x4*)((bf16_t*)p.out + DOUT_GQD + (size_t)lit * 4096 + (tid >> 3) * 64 + (tid & 7) * 8) = *(const u32x4*)(smem + GL_QD + (tid >> 3) * 144 + (tid & 7) * 16); }
#pragma unroll
        for (int tt = 0; tt < 2; ++tt) { const int tile = wid * 2 + tt, st = tile >> 2, ct = tile & 3; f32x4 a = Z4;
#pragma unroll
            for (int ks = 0; ks < 2; ++ks) { const int co = (32 * ks + 8 * fq) * 2; a = mfma16(ldsfrag(smem, GL_KTL + (16 * st + fr) * 144 + co), ldsfrag(smem, GL_QT + (16 * ct + fr) * 144 + co), a); }
            const int c = 16 * ct + fr; float v[4];
#pragma unroll
            for (int r = 0; r < 4; ++r) { const int sidx = 16 * st + 4 * fq + r; v[r] = (dir ? sidx >= c : sidx <= c) ? a[r] : 0.f; }
            u32x2 w; w.x = cvt_pk_bf16(v[0], v[1]); w.y = cvt_pk_bf16(v[2], v[3]); *(u32x2*)(smem + GL_ATT + c * 144 + (16 * st + 4 * fq) * 2) = w; }
        lds_barrier();
        bf16_t* OG = (bf16_t*)(ws + OFF_OGLA) + (size_t)dir * T_LAT * 512; const size_t row0 = (size_t)b * SEQ + (size_t)(j - 4) * 64;
        bf16x8 vb[2];
#pragma unroll
        for (int ks = 0; ks < 2; ++ks) vb[ks] = ldsfrag(smem, GL_VT + (16 * wid + fr) * 144 + (32 * ks + 8 * fq) * 2);
#pragma unroll
        for (int mt = 0; mt < 4; ++mt) { f32x4 o = Z4;
#pragma unroll
            for (int ks = 0; ks < 2; ++ks) o = mfma16(ldsfrag(smem, GL_ATT + (16 * mt + fr) * 144 + (32 * ks + 8 * fq) * 2), vb[ks], o);
#pragma unroll
            for (int r = 0; r < 4; ++r) OG[(row0 + 16 * mt + 4 * fq + r) * 512 + h * 128 + 16 * wid + fr] = f2bf(o[r]); }
    }
    lds_barrier();
    }
#undef GLAPRE_LOAD
}
constexpr int GS2_QD = 0, GS2_KDT = 9216, GS2_VT = 18432, GS2_ST = 36864;
DI void gla_scan_chain(const Params& p, unsigned char* smem, int cid, int half) {
    const int tid = threadIdx.x, lane = tid & 63, wid = tid >> 6, fr = lane & 15, fq = lane >> 4;
    const int b = cid >> 3, h = (cid >> 1) & 3, dir = cid & 1;
    unsigned char* ws = p.ws;
    const bf16_t* P2 = (const bf16_t*)(ws + OFF_P2);
    bf16_t* OG = (bf16_t*)(ws + OFF_OGLA) + (size_t)dir * T_LAT * 512;
    const int cw = wid & 3, ecol0 = half * 64 + 16 * cw;
    const int STo = GS2_ST + cw * 2304;
    f32x4 S[4];
#pragma unroll
    for (int i = 0; i < 4; ++i) S[i] = Z4;
    if (wid < 4) for (int i = lane; i < 2304 / 16; i += 64) *(u32x4*)(smem + STo + i * 16) = (u32x4){0u, 0u, 0u, 0u};
    struct Pf { u32x4 rq, rk, rv[2]; f32x4 rgl[4]; bf16_t ro[16]; };
    Pf pfA, pfB;
#define GLA2_PREFETCH(PF, jn) do { const int item_ = (((b * 132 + (jn)) * 4 + h) * 2) + dir; const size_t r0_ = chunk_row0(b, (jn)); \
        (PF).rk = *(const u32x4*)((const bf16_t*)(ws + OFF_GKDT) + (size_t)item_ * 4096 + (tid >> 3) * 64 + (tid & 7) * 8); \
        _Pragma("unroll") for (int q_ = 0; q_ < 2; ++q_) { const int pid_ = tid + 512 * q_; (PF).rv[q_] = *(const u32x4*)(P2 + (r0_ + (pid_ & 63)) * 2048 + 1024 + h * 128 + (pid_ >> 6) * 8); } \
        _Pragma("unroll") for (int md_ = 0; md_ < 4; ++md_) (PF).rgl[md_] = *(const f32x4*)((const float*)(ws + OFF_GGL) + (size_t)item_ * 64 + 16 * md_ + 4 * fq); \
        if ((jn) >= 4) { const int lit_ = ((b * 128 + ((jn) - 4)) * 4 + h) * 2 + dir; (PF).rq = *(const u32x4*)((const bf16_t*)p.out + DOUT_GQD + (size_t)lit_ * 4096 + (tid >> 3) * 64 + (tid & 7) * 8); \
            const size_t row0_ = (size_t)b * SEQ + (size_t)((jn) - 4) * 64; \
            _Pragma("unroll") for (int i_ = 0; i_ < 16; ++i_) (PF).ro[i_] = OG[(row0_ + 16 * (i_ >> 2) + 4 * fq + (i_ & 3)) * 512 + h * 128 + ecol0 + fr]; } } while (0)
    GLA2_PREFETCH(pfA, dir ? 3 : 0); GLA2_PREFETCH(pfB, dir ? 2 : 1);
    unsigned pfv = 0u, pfacc = 0u;
#define GLA2_WARM(jn) do { const int item_ = (((b * 132 + (jn)) * 4 + h) * 2) + dir; const size_t r0_ = chunk_row0(b, (jn)); const bf16_t* a_ = nullptr; \
        if (tid < 64) a_ = (const bf16_t*)(ws + OFF_GKDT) + (size_t)item_ * 4096 + tid * 64; \
        else if (tid < 128) { if ((jn) >= 4) a_ = (const bf16_t*)p.out + DOUT_GQD + (size_t)(((b * 128 + ((jn) - 4)) * 4 + h) * 2 + dir) * 4096 + (tid - 64) * 64; } \
        else if (tid < 256) a_ = P2 + (r0_ + ((tid - 128) >> 1)) * 2048 + 1024 + h * 128 + ((tid - 128) & 1) * 64; \
        else if (tid < 384) { if ((jn) >= 4) a_ = OG + ((size_t)b * SEQ + (size_t)((jn) - 4) * 64 + ((tid - 256) >> 1)) * 512 + h * 128 + ((tid - 256) & 1) * 64; } \
        else if (tid < 386) a_ = (const bf16_t*)((const float*)(ws + OFF_GGL) + (size_t)item_ * 64 + (tid - 384) * 32); \
        if (a_) pfv = *(const unsigned*)a_; } while (0)
    auto step = [&](Pf& pf, const int s) __attribute__((always_inline)) {
        const int j = dir ? (s < 4 ? 3 - s : 135 - s) : s;
        if (j >= 4) *(u32x4*)(smem + GS2_QD + (tid >> 3) * 144 + (tid & 7) * 16) = pf.rq;
        *(u32x4*)(smem + GS2_KDT + (tid >> 3) * 144 + (tid & 7) * 16) = pf.rk;
#pragma unroll
        for (int q = 0; q < 2; ++q) { const int pid = tid + 512 * q, c = pid & 63, e0 = (pid >> 6) * 8;
#pragma unroll
            for (int e = 0; e < 4; ++e) { *(bf16_t*)(smem + GS2_VT + (e0 + 2 * e) * 144 + c * 2) = (bf16_t)(pf.rv[q][e] & 0xffffu); *(bf16_t*)(smem + GS2_VT + (e0 + 2 * e + 1) * 144 + c * 2) = (bf16_t)(pf.rv[q][e] >> 16); } }
        f32x4 glv[4]; f32x4 o[4];
#pragma unroll
        for (int md = 0; md < 4; ++md) glv[md] = pf.rgl[md];
#pragma unroll
        for (int mt = 0; mt < 4; ++mt) o[mt] = (f32x4){bf2f(pf.ro[4 * mt]), bf2f(pf.ro[4 * mt + 1]), bf2f(pf.ro[4 * mt + 2]), bf2f(pf.ro[4 * mt + 3])};
        lds_barrier();
        if (s + 2 < 132) { const int jn = dir ? (s + 2 < 4 ? 3 - (s + 2) : 135 - (s + 2)) : s + 2; GLA2_PREFETCH(pf, jn); }
        if (wid < 4) {
        __builtin_amdgcn_s_setprio(2);
        if (j >= 4) { const size_t row0 = (size_t)b * SEQ + (size_t)(j - 4) * 64;
            bf16x8 sb[2];
#pragma unroll
            for (int ks = 0; ks < 2; ++ks) sb[ks] = ldsfrag(smem, STo + fr * 144 + (32 * ks + 8 * fq) * 2);
#pragma unroll
            for (int mt = 0; mt < 4; ++mt) {
#pragma unroll
                for (int ks = 0; ks < 2; ++ks) o[mt] = mfma16(ldsfrag(smem, GS2_QD + (16 * mt + fr) * 144 + (32 * ks + 8 * fq) * 2), sb[ks], o[mt]);
#pragma unroll
                for (int r = 0; r < 4; ++r) OG[(row0 + 16 * mt + 4 * fq + r) * 512 + h * 128 + ecol0 + fr] = f2bf(o[mt][r]); } }
        bf16x8 vb[2];
#pragma unroll
        for (int ks = 0; ks < 2; ++ks) vb[ks] = ldsfrag(smem, GS2_VT + (ecol0 + fr) * 144 + (32 * ks + 8 * fq) * 2);
#pragma unroll
        for (int md = 0; md < 4; ++md) { f32x4 a = S[md] * glv[md];
#pragma unroll
            for (int ks = 0; ks < 2; ++ks) a = mfma16(ldsfrag(smem, GS2_KDT + (16 * md + fr) * 144 + (32 * ks + 8 * fq) * 2), vb[ks], a);
            S[md] = a;
            u32x2 w; w.x = cvt_pk_bf16(a[0], a[1]); w.y = cvt_pk_bf16(a[2], a[3]); *(u32x2*)(smem + STo + fr * 144 + (16 * md + 4 * fq) * 2) = w; }
        __builtin_amdgcn_s_setprio(0);
        }
        lds_barrier();
    };
    for (int s2 = 0; s2 < 132; s2 += 2) { step(pfA, s2); step(pfB, s2 + 1); }
#undef GLA2_PREFETCH
#undef GLA2_WARM
    asm volatile("" :: "v"(pfacc));
}
DI void merge_phase(const Params& p) {
    const int lane = threadIdx.x & 63, wid = threadIdx.x >> 6; unsigned char* ws = p.ws;
    const bf16_t* P2 = (const bf16_t*)(ws + OFF_P2); bf16_t* Y = (bf16_t*)(ws + OFF_Y);
    const int half = lane >> 5, col = (lane & 31) * 16;
    const bf16_t* O0 = (const bf16_t*)(ws + (half ? OFF_OGLA : OFF_OGDN)); const bf16_t* O1 = O0 + (size_t)T_LAT * 512;
    const float* nw = (half ? p.gla_norm_w : p.gdn_norm_w) + (col & 127);
    for (int r = blockIdx.x * 8 + wid; r < T_LAT; r += gridDim.x * 8) {
        float o[16]; float ss = 0.f;
#pragma unroll
        for (int q = 0; q < 2; ++q) { const u32x4 a = *(const u32x4*)(O0 + (size_t)r * 512 + col + q * 8), c = *(const u32x4*)(O1 + (size_t)r * 512 + col + q * 8);
#pragma unroll
            for (int e = 0; e < 4; ++e) { const float v0 = bflo(a[e]) + bflo(c[e]), v1 = bfhi(a[e]) + bfhi(c[e]); o[q * 8 + 2 * e] = v0; o[q * 8 + 2 * e + 1] = v1; ss += v0 * v0 + v1 * v1; } }
        ss += __shfl_xor(ss, 1); ss += __shfl_xor(ss, 2); ss += __shfl_xor(ss, 4);
        const float rs = rsqrtf(ss * (1.f / 128.f) + 1e-6f);
        const bf16_t* zp = P2 + (size_t)r * 2048 + (half ? 1536 : 0) + col; u32x4 w[2];
#pragma unroll
        for (int q = 0; q < 2; ++q) { const u32x4 z = *(const u32x4*)(zp + q * 8);
#pragma unroll
            for (int e = 0; e < 4; ++e) { const float y0 = o[q * 8 + 2 * e] * rs * nw[q * 8 + 2 * e] * siluf(bflo(z[e])), y1 = o[q * 8 + 2 * e + 1] * rs * nw[q * 8 + 2 * e + 1] * siluf(bfhi(z[e])); w[q][e] = cvt_pk_bf16(y0, y1); } }
        *(u32x4*)(Y + (size_t)r * 1024 + half * 512 + col) = w[0]; *(u32x4*)(Y + (size_t)r * 1024 + half * 512 + col + 8) = w[1];
    }
}
typedef _Float16 h16x2 __attribute__((ext_vector_type(2)));
typedef _Float16 h16x4 __attribute__((ext_vector_type(4)));
typedef f32x2 cf;
DI cf cmul(cf a, cf b) { return (cf){a.x, a.x} * b + (cf){a.y, a.y} * (cf){-b.y, b.x}; }
DI cf cadd(cf a, cf b) { return a + b; }
DI cf csub(cf a, cf b) { return a - b; }
template <int SGN> DI cf mulI(cf a) { return SGN < 0 ? (cf){a.y, -a.x} : (cf){-a.y, a.x}; }
template <int SGN> DI void dft4(cf& a0, cf& a1, cf& a2, cf& a3) {
    const cf s02 = cadd(a0, a2), d02 = csub(a0, a2), s13 = cadd(a1, a3), d13 = mulI<SGN>(csub(a1, a3));
    a0 = cadd(s02, s13); a2 = csub(s02, s13); a1 = cadd(d02, d13); a3 = csub(d02, d13);
}
template <int SGN> DI void dft16(cf (&x)[16]) {
    constexpr float C1 = 0.92387953251128674f, S1 = 0.38268343236508977f, C2 = 0.70710678118654752f;
#pragma unroll
    for (int m1 = 0; m1 < 4; ++m1) dft4<SGN>(x[m1], x[m1 + 4], x[m1 + 8], x[m1 + 12]);
#define TW(idx, c, s) x[idx] = cmul(x[idx], (cf){(c), SGN * (s)})
    TW(1 + 4, C1, S1); TW(1 + 8, C2, C2); TW(1 + 12, S1, C1);
    TW(2 + 4, C2, C2); x[2 + 8] = mulI<SGN>(x[2 + 8]); TW(2 + 12, -C2, C2);
    TW(3 + 4, S1, C1); TW(3 + 8, -C2, C2); TW(3 + 12, -C1, -S1);
#undef TW
#pragma unroll
    for (int k2 = 0; k2 < 4; ++k2) dft4<SGN>(x[4 * k2], x[4 * k2 + 1], x[4 * k2 + 2], x[4 * k2 + 3]);
#pragma unroll
    for (int a = 0; a < 4; ++a)
#pragma unroll
        for (int bb = a + 1; bb < 4; ++bb) { const cf t = x[4 * a + bb]; x[4 * a + bb] = x[4 * bb + a]; x[4 * bb + a] = t; }
}
DI int launder(int v) { asm volatile("" : "+v"(v)); return v; }
DI int fpad(int e) { return e + ((e >> 6) << 2); }
constexpr int FFT_LDS_ELEMS = 16384 + 1024;
template <int SGN> DI void twiddles(float f, cf (&w)[16]) {
    w[1] = (cf){__builtin_amdgcn_cosf(f), SGN * __builtin_amdgcn_sinf(f)}; const float f2 = __builtin_amdgcn_fractf(2.f * f), f4 = __builtin_amdgcn_fractf(4.f * f), f8 = __builtin_amdgcn_fractf(8.f * f);
    w[2] = (cf){__builtin_amdgcn_cosf(f2), SGN * __builtin_amdgcn_sinf(f2)}; w[4] = (cf){__builtin_amdgcn_cosf(f4), SGN * __builtin_amdgcn_sinf(f4)}; w[8] = (cf){__builtin_amdgcn_cosf(f8), SGN * __builtin_amdgcn_sinf(f8)};
    w[3] = cmul(w[2], w[1]); w[5] = cmul(w[4], w[1]); w[6] = cmul(w[4], w[2]); w[7] = cmul(w[4], w[3]);
    w[9] = cmul(w[8], w[1]); w[10] = cmul(w[8], w[2]); w[11] = cmul(w[8], w[3]); w[12] = cmul(w[8], w[4]); w[13] = cmul(w[8], w[5]); w[14] = cmul(w[8], w[6]); w[15] = cmul(w[8], w[7]);
}
template <int SGN, int LGN, int MODE = 0> DI void fft_pass16(cf* X, int tid) {
    constexpr int n = 1 << LGN, st = n >> 4, pst = st >= 64 ? st + ((st >> 6) << 2) : st;
#pragma unroll
    for (int qq = 0; qq < 2; ++qq) { const int q = tid + 512 * qq, blk = q >> (LGN - 4), i = q & (st - 1); cf* xp = X + fpad(blk * n + i);
        cf x[16], w[16];
#pragma unroll
        for (int m = 0; m < 16; ++m) x[m] = (MODE == 1 && m >= 8) ? (cf){0.f, 0.f} : xp[m * pst];
        twiddles<SGN>((float)i * (1.f / (float)n), w);
        if (SGN > 0) {
#pragma unroll
            for (int k = 1; k < 16; ++k) x[k] = cmul(x[k], w[k]); }
        dft16<SGN>(x);
        if (SGN < 0) {
#pragma unroll
            for (int k = 1; k < 16; ++k) x[k] = cmul(x[k], w[k]); }
#pragma unroll
        for (int m = 0; m < 16; ++m) if (!(MODE == 2 && m >= 8)) xp[m * pst] = x[m];
    }
}
template <int SGN> DI void fft_pass4(cf* X, int tid) {
#pragma unroll 2
    for (int qq = 0; qq < 8; ++qq) { const int q = tid + 512 * qq; f32x4* pp = (f32x4*)(X + fpad(4 * q)); f32x4 a = pp[0], b = pp[1];
        cf x0{a[0], a[1]}, x1{a[2], a[3]}, x2{b[0], b[1]}, x3{b[2], b[3]}; dft4<SGN>(x0, x1, x2, x3);
        pp[0] = (f32x4){x0.x, x0.y, x1.x, x1.y}; pp[1] = (f32x4){x2.x, x2.y, x3.x, x3.y}; }
}
DI void fft_fwd(cf* X, int tid) { fft_pass16<-1, 14>(X, launder(tid)); __syncthreads(); fft_pass16<-1, 10>(X, launder(tid)); __syncthreads(); fft_pass16<-1, 6>(X, launder(tid)); __syncthreads(); fft_pass4<-1>(X, launder(tid)); __syncthreads(); }
DI void fft_fwd_hz(cf* X, int tid) { fft_pass16<-1, 14, 1>(X, launder(tid)); __syncthreads(); fft_pass16<-1, 10>(X, launder(tid)); __syncthreads(); fft_pass16<-1, 6>(X, launder(tid)); __syncthreads(); fft_pass4<-1>(X, launder(tid)); __syncthreads(); }
DI void fft_inv_lo(cf* X, int tid) { fft_pass4<1>(X, launder(tid)); __syncthreads(); fft_pass16<1, 6>(X, launder(tid)); __syncthreads(); fft_pass16<1, 10>(X, launder(tid)); __syncthreads(); fft_pass16<1, 14, 2>(X, launder(tid)); __syncthreads(); }
DI void fft_inv(cf* X, int tid) { fft_pass4<1>(X, launder(tid)); __syncthreads(); fft_pass16<1, 6>(X, launder(tid)); __syncthreads(); fft_pass16<1, 10>(X, launder(tid)); __syncthreads(); fft_pass16<1, 14>(X, launder(tid)); __syncthreads(); }

DI void hy_hdn_phase(const Params& p) {
    const int lane = threadIdx.x & 63, wid = threadIdx.x >> 6; bf16_t* HDN = (bf16_t*)(p.ws + OFF_HDN);
    const float frq = p.hy_freq[lane];
    for (int l = blockIdx.x * 8 + wid; l < SEQ; l += gridDim.x * 8) {
        float zv = 0.f;
        if (lane == 0) zv = (float)l / 8191.f;
        else if (lane < 33) { const int bnd = (lane - 1) & 15; const float f = 1e-4f + (float)bnd * ((15.f - 1e-4f) / 15.f), w = (6.283185307179586f / 8192.f) * (float)l; zv = lane < 17 ? cosf(f * w) : -sinf(f * w); }
        float a = p.hy_pos_b1[lane];
        for (int i = 0; i < 33; ++i) a += __shfl(zv, i) * p.hy_pos_w1[i * 64 + lane];
        float h1 = sinf(frq * a);
        a = p.hy_pos_b2[lane];
        for (int i = 0; i < 64; ++i) a += __shfl(h1, i) * p.hy_pos_w2[i * 64 + lane];
        float h2 = sinf(frq * a);
        a = p.hy_pos_b3[lane];
        for (int i = 0; i < 64; ++i) a += __shfl(h2, i) * p.hy_pos_w3[i * 64 + lane];
        HDN[l * 64 + lane] = f2bf(sinf(frq * a));
    }
}
constexpr size_t OFF_FOT = OFF_HDN + MiB;
DI void hy_filt_item(const Params& p, unsigned char* smem, int item) {
    int tid_ = threadIdx.x; asm volatile("" : "+v"(tid_)); const int tid = tid_, lane = tid & 63, wid = tid >> 6, fr = lane & 15, fq = lane >> 4;
    const int lt = item & 15, ct = item >> 4, l0 = lt * 512 + wid * 64, c0 = ct * 64;
    const bf16_t* HD = (const bf16_t*)(p.ws + OFF_HDN); const bf16_t* FT = (const bf16_t*)(p.ws + OFF_FOT); _Float16* HT = (_Float16*)(p.ws + OFF_HT);
    const float dmin = -3.0701134573253944f, dmax = -15.350567286626972f;
    bf16x8 af[4][2];
#pragma unroll
    for (int mt = 0; mt < 4; ++mt)
#pragma unroll
        for (int ks = 0; ks < 2; ++ks) af[mt][ks] = *(const bf16x8*)(HD + (size_t)(l0 + 16 * mt + fr) * 64 + 32 * ks + 8 * fq);
#pragma unroll
    for (int nt = 0; nt < 4; ++nt) { const int c = c0 + 16 * nt + fr; bf16x8 bfr[2];
#pragma unroll
        for (int ks = 0; ks < 2; ++ks) bfr[ks] = *(const bf16x8*)(FT + (size_t)c * 64 + 32 * ks + 8 * fq);
        const float delta = fabsf(dmin + (dmax - dmin) * ((float)(c & 1023) / 1023.f));
#pragma unroll
        for (int mt = 0; mt < 4; ++mt) { f32x4 acc = Z4;
#pragma unroll
            for (int ks = 0; ks < 2; ++ks) acc = mfma16(af[mt][ks], bfr[ks], acc);
            const int l = l0 + 16 * mt + 4 * fq; _Float16 o[4];
#pragma unroll
            for (int r = 0; r < 4; ++r) o[r] = (_Float16)(acc[r] * (__expf(-((float)(l + r) / 8191.f) * delta) + 0.05f));
            *(u32x2*)(HT + (size_t)c * SEQ + l) = __builtin_bit_cast(u32x2, *(const h16x4*)o); } }
}
DI int fft_pos2freq(int p) { return (p >> 10) + (((p >> 6) & 15) << 4) + (((p >> 2) & 15) << 8) + ((p & 3) << 12); }
DI int fft_freq2pos(int f) { return ((f & 15) << 10) + (((f >> 4) & 15) << 6) + (((f >> 8) & 15) << 2) + (f >> 12); }
DI void hy_spec_item(const Params& p, unsigned char* smem, int item) {
    int tid_ = threadIdx.x; asm volatile("" : "+v"(tid_)); const int tid = tid_, d = item; cf* X = (cf*)smem;
    const _Float16* HTp = (const _Float16*)(p.ws + OFF_HT);
    const _Float16* hf0 = HTp + (size_t)d * SEQ; const _Float16* hf1 = HTp + (size_t)(1024 + d) * SEQ; const _Float16* hb0 = HTp + (size_t)(2048 + d) * SEQ; const _Float16* hb1 = HTp + (size_t)(3072 + d) * SEQ;
    for (int m = tid; m < SEQ; m += 512) { X[fpad(m)] = (cf){(float)hf0[m], (float)hf1[m]}; X[fpad(m == 0 ? 8192 : 16384 - m)] = m == 0 ? (cf){0.f, 0.f} : (cf){(float)hb0[m], (float)hb1[m]}; }
    __syncthreads();
    fft_fwd(X, tid);
    h16x2* SP0 = (h16x2*)(p.ws + OFF_SPEC) + (size_t)d * 16384; h16x2* SP1 = SP0 + (size_t)1024 * 16384;
    for (int e = tid; e < 16384; e += 512) { const int f = fft_pos2freq(e), e2 = fft_freq2pos((16384 - f) & 16383); const cf z = X[fpad(e)], zm = X[fpad(e2)];
        h16x2 o0, o1; o0.x = (_Float16)(0.5f * (z.x + zm.x) + p.hy_skip[d]); o0.y = (_Float16)(0.5f * (z.y - zm.y)); o1.x = (_Float16)(0.5f * (z.y + zm.y) + p.hy_skip[1024 + d]); o1.y = (_Float16)(-0.5f * (z.x - zm.x));
        SP0[e] = o0; SP1[e] = o1; }
    __syncthreads();
}
DI void hy_sc8(const bf16_t* row, int t, float w0, float w1, float w2, float (&o)[8]) {
    const u32x4 v = *(const u32x4*)(row + t); float x[10]; x[0] = t > 0 ? bf2f(row[t - 1]) : 0.f; x[9] = t + 8 < SEQ ? bf2f(row[t + 8]) : 0.f;
#pragma unroll
    for (int e = 0; e < 4; ++e) { x[1 + 2 * e] = bflo(v[e]); x[2 + 2 * e] = bfhi(v[e]); }
#pragma unroll
    for (int i = 0; i < 8; ++i) o[i] = w0 * x[i] + w1 * x[i + 1] + w2 * x[i + 2];
}
DI void hy_spec_load(const h16x2* SP, int tid, h16x2 (&kr)[32]) {
#pragma unroll
    for (int u = 0; u < 32; ++u) kr[u] = SP[tid + 512 * u];
}
DI void hy_spec_mul(cf* X, const h16x2 (&kr)[32], int tid) {
#pragma unroll
    for (int u = 0; u < 32; ++u) { cf* xp = X + fpad(tid + 512 * u); *xp = cmul(*xp, (cf){(float)kr[u].x * (1.f / 16384.f), (float)kr[u].y * (1.f / 16384.f)}); }
    __syncthreads();
}
DI void hy_conv_item(const Params& p, unsigned char* smem, int item) {
    int tid_ = threadIdx.x; asm volatile("" : "+v"(tid_)); const int tid = tid_, d = item >> 1, pair = item & 1; cf* X = (cf*)smem;
    const bf16_t* UT = (const bf16_t*)(p.ws + OFF_UT); bf16_t* ZT = (bf16_t*)(p.ws + OFF_ZT);
    const h16x2* SP0 = (const h16x2*)(p.ws + OFF_SPEC) + (size_t)d * 16384; const h16x2* SP1 = SP0 + (size_t)1024 * 16384;
    const float* cw = p.hy_conv_w;
    const size_t boff = (size_t)pair * 2 * SEQ;
    bf16_t* o0 = ZT + (size_t)d * T_LAT + boff; bf16_t* o1 = o0 + SEQ;
    { const float w0 = cw[d], w1 = cw[3072 + d], w2 = cw[6144 + d]; const bf16_t* r0 = UT + (size_t)d * T_LAT + boff; const bf16_t* r1 = r0 + SEQ;
#pragma unroll
      for (int q = 0; q < 2; ++q) { const int t = 8 * (tid + 512 * q); float a0[8], a1[8]; hy_sc8(r0, t, w0, w1, w2, a0); hy_sc8(r1, t, w0, w1, w2, a1);
          f32x4* xp = (f32x4*)(X + fpad(t));
#pragma unroll
          for (int i = 0; i < 4; ++i) { xp[i] = (f32x4){a0[2 * i], a1[2 * i], a0[2 * i + 1], a1[2 * i + 1]}; } } }
    __syncthreads();
    { h16x2 kr[32]; hy_spec_load(SP0, tid, kr); fft_fwd_hz(X, launder(tid)); hy_spec_mul(X, kr, launder(tid)); }
    fft_inv_lo(X, launder(tid));
    { const int ch = 1024 + d; const float w0 = cw[ch], w1 = cw[3072 + ch], w2 = cw[6144 + ch]; const bf16_t* r0 = UT + (size_t)ch * T_LAT + boff; const bf16_t* r1 = r0 + SEQ;
#pragma unroll
      for (int q = 0; q < 2; ++q) { const int t = 8 * (tid + 512 * q); float g0[8], g1[8]; hy_sc8(r0, t, w0, w1, w2, g0); hy_sc8(r1, t, w0, w1, w2, g1);
          f32x4* xp = (f32x4*)(X + fpad(t));
#pragma unroll
          for (int i = 0; i < 4; ++i) { const f32x4 y = xp[i]; xp[i] = (f32x4){y[0] * g0[2 * i], y[1] * g1[2 * i], y[2] * g0[2 * i + 1], y[3] * g1[2 * i + 1]}; } } }
    __syncthreads();
    { h16x2 kr[32]; hy_spec_load(SP1, tid, kr); fft_fwd_hz(X, launder(tid)); hy_spec_mul(X, kr, launder(tid)); }
    fft_inv_lo(X, launder(tid));
    { const int ch = 2048 + d; const float w0 = cw[ch], w1 = cw[3072 + ch], w2 = cw[6144 + ch]; const bf16_t* r0 = UT + (size_t)ch * T_LAT + boff; const bf16_t* r1 = r0 + SEQ;
#pragma unroll
      for (int q = 0; q < 2; ++q) { const int t = 8 * (tid + 512 * q); float g0[8], g1[8]; hy_sc8(r0, t, w0, w1, w2, g0); hy_sc8(r1, t, w0, w1, w2, g1);
          const f32x4* xp = (const f32x4*)(X + fpad(t)); u32x4 s0, s1;
#pragma unroll
          for (int i = 0; i < 4; ++i) { const f32x4 y = xp[i]; s0[i] = cvt_pk_bf16(y[0] * g0[2 * i], y[2] * g0[2 * i + 1]); s1[i] = cvt_pk_bf16(y[1] * g1[2 * i], y[3] * g1[2 * i + 1]); }
          *(u32x4*)(o0 + t) = s0; *(u32x4*)(o1 + t) = s1; } }
    __syncthreads();
}
DI void hy_transpose_phase(const Params& p, unsigned char* smem) {
    const int tid = threadIdx.x; const bf16_t* ZT = (const bf16_t*)(p.ws + OFF_ZT); bf16_t* Z = (bf16_t*)(p.ws + OFF_Z); bf16_t* tl = (bf16_t*)smem;
    for (int u = blockIdx.x; u < 16 * 512; u += gridDim.x) { const int ct = u & 15, tt = u >> 4, r = tid >> 3, pc = tid & 7;
        const u32x4 v = *(const u32x4*)(ZT + (size_t)(ct * 64 + r) * T_LAT + tt * 64 + pc * 8);
#pragma unroll
        for (int e = 0; e < 4; ++e) { tl[(pc * 8 + 2 * e) * 72 + r] = (bf16_t)(v[e] & 0xffffu); tl[(pc * 8 + 2 * e + 1) * 72 + r] = (bf16_t)(v[e] >> 16); }
        __syncthreads();
        *(u32x4*)(Z + (size_t)(tt * 64 + r) * 1024 + ct * 64 + pc * 8) = *(const u32x4*)(tl + r * 72 + pc * 8);
        __syncthreads(); }
}
template <int LAYER> DI void ffn_block(const Params& p, unsigned char* smem, const XcdBarrier& xb) {
    unsigned char* ws = p.ws; const float* mv = (const float*)(ws + OFF_MODV) + (size_t)LAYER * 5 * 6144; bf16_t* Abuf = (bf16_t*)(ws + OFF_A);
    norm_phase(p.out, nullptr, Abuf, T_LAT, p.norm2_w + LAYER * 1024, mv, 3072, 4096);
    xcd_barrier(xb);
    { pg8::EpiSwiglu E{(bf16_t*)(ws + OFF_HID)}; run_gemm(smem, Abuf, (const bf16_t*)(ws + (LAYER ? OFF_W1_F1 : OFF_W0_F1)), T_LAT, 5632, 1024, E); }
    xcd_barrier(xb);
    { pg8::EpiResid E{p.out, p.out, mv + 5120}; run_gemm(smem, (const bf16_t*)(ws + OFF_HID), (const bf16_t*)(ws + (LAYER ? OFF_W1_F2 : OFF_W0_F2)), T_LAT, 1024, 2816, E); }
    xcd_barrier(xb);
}
__global__ void __launch_bounds__(512) mega(Params p) {
    extern __shared__ __attribute__((aligned(16))) unsigned char smem[];
    cg::grid_group grid = cg::this_grid();
    if (threadIdx.x < 4) ((volatile LAS unsigned*)(smem + LDS_XB_ST))[threadIdx.x] = 0u;
    __syncthreads();
    const XcdBarrier xb = xcd_barrier_post((unsigned*)(p.ws + OFF_BAR), (volatile LAS unsigned*)(smem + LDS_XB_ST));
    unsigned char* ws = p.ws;
    float* modv = (float*)(ws + OFF_MODV);
    bf16_t* Abuf = (bf16_t*)(ws + OFF_A);
    { int cb = 0;
      cb = conv_job(cb, (bf16_t*)(ws + OFF_W0_ABIN), 1024, 3840, 1, p.ab_w_in, nullptr, 3632);
      cb = conv_job(cb, (bf16_t*)(ws + OFF_W0_ABOUT), 1024, 1024, 0, p.ab_w_out, nullptr, 1024);
      cb = conv_job(cb, (bf16_t*)(ws + OFF_W0_F1), 1024, 5632, 2, p.ffn_w1, p.ffn_w3, 2816);
      cb = conv_job(cb, (bf16_t*)(ws + OFF_W0_F2), 2816, 1024, 0, p.ffn_w2, nullptr, 1024);
      cb = conv_job(cb, (bf16_t*)(ws + OFF_HDN + MiB), 64, 4096, 0, p.hy_filt_out, nullptr, 4096);
      for (int it = blockIdx.x; it < 192; it += gridDim.x) modvec_item(p, it, (float*)smem);
      hy_hdn_phase(p); }
    if (p.out == nullptr) grid.sync();
    xcd_barrier(xb);
    norm_phase(p.x, p.ctx, Abuf, T_ALL, p.norm1_w, modv, 0, 1024);
    xcd_barrier(xb);
    { pg8::EpiAbIn E{(bf16_t*)(ws + OFF_R), (bf16_t*)(ws + OFF_P2), (float*)(ws + OFF_G)}; run_gemm(smem, Abuf, (const bf16_t*)(ws + OFF_W0_ABIN), T_ALL, 3840, 1024, E); }
    xcd_barrier(xb);
    {
      unsigned* qctr = (unsigned*)(p.ws + OFF_BAR); volatile LAS unsigned* qs = (volatile LAS unsigned*)(smem + LDS_XB_ST + 8);
      int it = blockIdx.x;
      for (int k = 0; it < 2112; ++k) {
          if (threadIdx.x == 0) qs[(k + 1) & 1] = gridDim.x + __hip_atomic_fetch_add(qctr, 1u, __ATOMIC_RELAXED, __HIP_MEMORY_SCOPE_AGENT);
          gdn_prep_item(p, smem, it);
          it = (int)qs[(k + 1) & 1]; } }
    xcd_barrier(xb);
    gla_pre_phase(p, smem);
    xcd_barrier(xb);
    if (blockIdx.x < 128) gdn_scan_chain(p, smem, blockIdx.x >> 2, blockIdx.x & 3);
    else if (blockIdx.x < 192) gla_scan_chain(p, smem, (blockIdx.x - 128) >> 1, (blockIdx.x - 128) & 1);
    xcd_barrier(xb);
    merge_phase(p);
    { int cb = 0;
      cb = conv_job(cb, (bf16_t*)(ws + OFF_W1_HYIN), 1024, 3072, 0, p.hy_w_in, nullptr, 3072);
      cb = conv_job(cb, (bf16_t*)(ws + OFF_W1_HYOUT), 1024, 1024, 0, p.hy_w_out, nullptr, 1024);
      cb = conv_job(cb, (bf16_t*)(ws + OFF_W1_F1), 1024, 5632, 2, p.ffn_w1 + (size_t)1024 * 2816, p.ffn_w3 + (size_t)1024 * 2816, 2816);
      cb = conv_job(cb, (bf16_t*)(ws + OFF_W1_F2), 2816, 1024, 0, p.ffn_w2 + (size_t)2816 * 1024, nullptr, 1024); }
    xcd_barrier(xb);
    { pg8::EpiResid E{p.out, p.x, modv + 2048}; run_gemm(smem, (const bf16_t*)(ws + OFF_Y), (const bf16_t*)(ws + OFF_W0_ABOUT), T_LAT, 1024, 1024, E); }
    xcd_barrier(xb);
    ffn_block<0>(p, smem, xb);
    norm_phase(p.out, nullptr, Abuf, T_LAT, p.norm1_w + 1024, modv + 5 * 6144, 0, 1024);
    for (int it = blockIdx.x; it < 1024; it += gridDim.x) hy_filt_item(p, smem, it);
    xcd_barrier(xb);
    for (int it = blockIdx.x; it < 1024; it += gridDim.x) hy_spec_item(p, smem, it);
    xcd_barrier(xb);
    { pg8::EpiBf16Plain E{(bf16_t*)(ws + OFF_UT), (size_t)T_LAT}; run_gemm(smem, (const bf16_t*)(ws + OFF_W1_HYIN), Abuf, 3072, T_LAT, 1024, E); }
    xcd_barrier(xb);
    for (int it = blockIdx.x; it < 2048; it += gridDim.x) hy_conv_item(p, smem, it);
    xcd_barrier(xb);
    hy_transpose_phase(p, smem);
    xcd_barrier(xb);
    { pg8::EpiResid E{p.out, p.out, modv + 5 * 6144 + 2048}; run_gemm(smem, (const bf16_t*)(ws + OFF_Z), (const bf16_t*)(ws + OFF_W1_HYOUT), T_LAT, 1024, 1024, E); }
    xcd_barrier(xb);
    ffn_block<1>(p, smem, xb);
    final_norm_phase(p.out, p.final_norm_w);
}
extern "C" void kernel_launch(void* const* d_in, const int* in_sizes, int n_in, void* d_out, int out_size, void* d_ws, size_t ws_size, hipStream_t stream) {
    static int grid = 0;
    if (grid == 0) {
        int dev = 0, cus = 0, per_cu = 0;
        if (n_in != 33 || ws_size < WS_NEED) { fprintf(stderr, "kernel_launch: unexpected n_in %d / ws %zu (need %zu)\n", n_in, ws_size, (size_t)WS_NEED); grid = -1; return; }
        (void)hipGetDevice(&dev); (void)hipDeviceGetAttribute(&cus, hipDeviceAttributeMultiprocessorCount, dev);
        if (hipFuncSetAttribute((const void*)mega, hipFuncAttributeMaxDynamicSharedMemorySize, LDS_BYTES) != hipSuccess) { fprintf(stderr, "hipFuncSetAttribute failed\n"); grid = -1; return; }
        (void)hipOccupancyMaxActiveBlocksPerMultiprocessor(&per_cu, (const void*)mega, 512, LDS_BYTES);
        if (per_cu < 1) { fprintf(stderr, "occupancy query says %d blocks/CU\n", per_cu); per_cu = 1; }
        (void)hipGetLastError();
        grid = cus;
    }
    if (grid < 0) return;
    Params p{};
    const float** pp = (const float**)&p;
    for (int i = 0; i < 33; ++i) pp[i] = (const float*)d_in[i];
    p.out = (float*)d_out; p.ws = (unsigned char*)d_ws;
    if (hipMemsetAsync((char*)d_ws + OFF_BAR, 0, XCD_BAR_WORDS * sizeof(unsigned), stream) != hipSuccess) { fprintf(stderr, "memset of barrier words failed\n"); return; }
    void* args[] = {&p};
    hipError_t e = hipLaunchCooperativeKernel((const void*)mega, dim3(grid), dim3(512), args, LDS_BYTES, stream);
    if (e != hipSuccess) fprintf(stderr, "cooperative launch failed: %s (grid %d)\n", hipGetErrorString(e), grid);
}
```

```cpp
#include <hip/hip_runtime.h>
#include <hip/hip_cooperative_groups.h>
#include <cstdio>
#include <cmath>
namespace cg = cooperative_groups;

#define PG8_LAS __attribute__((address_space(3)))
typedef unsigned short bf16_t;
typedef short bf16x8 __attribute__((ext_vector_type(8)));
typedef float f32x4 __attribute__((ext_vector_type(4)));
typedef float f32x2 __attribute__((ext_vector_type(2)));
typedef unsigned u32x4 __attribute__((ext_vector_type(4)));
typedef unsigned u32x2 __attribute__((ext_vector_type(2)));
#define DI __device__ __forceinline__

typedef __bf16 bf16v2_t __attribute__((ext_vector_type(2)));
DI unsigned cvt_pk_bf16(float lo, float hi) { return __builtin_bit_cast(unsigned, __builtin_convertvector((f32x2){lo, hi}, bf16v2_t)); }
DI bf16_t f2bf(float x) { return (bf16_t)(cvt_pk_bf16(x, 0.f) & 0xffffu); }
DI float bf2f(bf16_t v) { return __uint_as_float(((unsigned)v) << 16); }
DI float bflo(unsigned w) { return __uint_as_float(w << 16); }
DI float bfhi(unsigned w) { return __uint_as_float(w & 0xffff0000u); }
DI float siluf(float x) { return x * __builtin_amdgcn_rcpf(1.f + __expf(-x)); }
DI float sigmoidf_(float x) { return __builtin_amdgcn_rcpf(1.f + __expf(-x)); }

namespace pg8 {
constexpr int BM = 256, BK = 64, HALF = 128, HTB = HALF * BK * 2, STAGE_BYTES = 8 * HTB, NXCD = 8, WGM = 4;
__host__ __device__ __forceinline__ int lds_byte(int r, int c) { const int st = (r >> 4) * 2 + (c >> 5), rr = r & 15, cc = c & 31, ob = rr * 64 + cc * 2; return st * 1024 + (ob ^ (((ob >> 9) & 1) << 5)); }
__host__ __device__ __forceinline__ void stage_rc(int b, int& R, int& C) { const int st = b / 1024, sb = b % 1024, swz = sb ^ (((sb >> 9) & 1) << 5); R = (st >> 1) * 16 + swz / 64; C = (st & 1) * 32 + (swz % 64) / 2; }
__host__ __device__ __forceinline__ int perm32(int rho) { const int n = rho >> 4, i = rho & 15; return 8 * (i >> 2) + 4 * n + (i & 3); }

struct Unit { int pm, pn; };
struct Gemm { const bf16_t* A; const bf16_t* Bt; int M, N, K; };

struct StaticOrder {
    int nM, nN, nwg, G, c;
    __host__ __device__ void init(int M, int N, int G_, int c_) { nM = M / BM; nN = N / BM; nwg = nM * nN; G = G_; c = c_; }
    __host__ __device__ bool next(int i, Unit& u) const {
        const long L = (long)i * G + c; if (L >= nwg) return false;
        int wgid = (int)L; { const int q = nwg / NXCD, r = nwg % NXCD, xcd = wgid % NXCD, off = wgid / NXCD; wgid = (xcd < r ? xcd * (q + 1) : r * (q + 1) + (xcd - r) * q) + off; }
        const int nig = WGM * nN, gid = wgid / nig, fm = gid * WGM, gsz = (nM - fm) < WGM ? (nM - fm) : WGM;
        u.pm = fm + ((wgid % nig) % gsz); u.pn = (wgid % nig) / gsz; return true;
    }
    __device__ __forceinline__ void a_ready(const Unit&) const {}
    __device__ __forceinline__ void done(const Unit&) const {}
};
template <class Epi, class Sched, bool ALIGN_EPI = false, bool SP2 = false>
__device__ __forceinline__ void gemm_phase(PG8_LAS unsigned char* lds, const Gemm g, const Sched& S, const Epi& E) {
    const int tid = threadIdx.x, wid = __builtin_amdgcn_readfirstlane(tid >> 6), lane = tid & 63, wr = wid >> 2, wc = wid & 3, fr = lane & 15, fq = lane >> 4;
    const int K = g.K, nt = K / BK;
    unsigned voffA[2], voffB[2];
#pragma unroll
    for (int i = 0; i < 2; ++i) { int R, C; stage_rc(tid * 16 + i * 8192, R, C); const int Rb = Epi::PERM ? ((R & ~31) + perm32(R & 31)) : R;
        voffA[i] = (unsigned)(R * K + C) * 2u; voffB[i] = (unsigned)(Rb * K + C) * 2u; }
    const size_t kstep = (size_t)(BK * 2);
    const size_t hstep = (size_t)HALF * K * 2;
    const size_t tstep = 2 * hstep;
    const unsigned ldsw = (unsigned)wid * 1024u;
    const int aoff = lds_byte(wr * 64 + fr, fq * 8), boff = lds_byte(wc * 32 + fr, fq * 8);
#define PG8_SA(b, h) (((b) * 2 + (h)) * HTB)
#define PG8_SB(b, h) ((4 + (b) * 2 + (h)) * HTB)
#define PG8_STAGE(bufoff, gbase, voff) do { _Pragma("unroll") for (int _i = 0; _i < 2; ++_i) \
        __builtin_amdgcn_global_load_lds((const unsigned*)((const char*)(gbase) + (voff)[_i]), (PG8_LAS unsigned*)(lds + (bufoff) + ldsw + _i * 8192), 16, 0, 0); } while (0)
#define PG8_LDA(dst, b, h) do { _Pragma("unroll") for (int m = 0; m < 4; ++m) _Pragma("unroll") for (int k = 0; k < 2; ++k) dst[m][k] = *(const PG8_LAS bf16x8*)(lds + PG8_SA(b, h) + aoff + m * 2048 + k * 1024); } while (0)
#define PG8_LDB(dst, b, h) do { _Pragma("unroll") for (int n = 0; n < 2; ++n) _Pragma("unroll") for (int k = 0; k < 2; ++k) dst[n][k] = *(const PG8_LAS bf16x8*)(lds + PG8_SB(b, h) + boff + n * 2048 + k * 1024); } while (0)
#define PG8_MMA(ai, bj, At, Bt) do { __builtin_amdgcn_s_setprio(1); _Pragma("unroll") for (int m = 0; m < 4; ++m) _Pragma("unroll") for (int n = 0; n < 2; ++n) _Pragma("unroll") for (int k = 0; k < 2; ++k) \
        acc[ai][bj][m][n] = __builtin_amdgcn_mfma_f32_16x16x32_bf16(Bt[n][k], At[m][k], acc[ai][bj][m][n], 0, 0, 0); __builtin_amdgcn_s_setprio(0); } while (0)
#define PG8_WAIT_V(n) asm volatile("s_waitcnt vmcnt(" #n ")" ::: "memory")
#define PG8_WAIT_L(n) asm volatile("s_waitcnt lgkmcnt(" #n ")" ::: "memory")
#define PG8_BAR __builtin_amdgcn_s_barrier()
#define PG8_SCHED __builtin_amdgcn_sched_barrier(0)
    Unit cur, nxt; int ui = 0;
    if (!S.next(0, cur)) return;
    f32x4 acc[2][2][4][2];
#pragma unroll
    for (int a = 0; a < 2; ++a)
#pragma unroll
        for (int b = 0; b < 2; ++b)
#pragma unroll
            for (int m = 0; m < 4; ++m)
#pragma unroll
                for (int n = 0; n < 2; ++n) acc[a][b][m][n] = (f32x4){0.f, 0.f, 0.f, 0.f};
    bf16x8 At[4][2], B0[2][2], B1[2][2];
    const char* cA = (const char*)g.A + (size_t)cur.pm * tstep; const char* cB = (const char*)g.Bt + (size_t)cur.pn * tstep;
    S.a_ready(cur);
    if constexpr (SP2) {
        PG8_STAGE(PG8_SB(0, 0), cB, voffB); PG8_STAGE(PG8_SB(0, 1), cB + hstep, voffB); PG8_STAGE(PG8_SA(0, 0), cA, voffA); PG8_STAGE(PG8_SA(0, 1), cA + hstep, voffA);
        if (wr == 1) PG8_BAR;
        PG8_WAIT_V(2); PG8_BAR;
        PG8_STAGE(PG8_SB(1, 0), cB + kstep, voffB); PG8_STAGE(PG8_SA(1, 0), cA + kstep, voffA); PG8_STAGE(PG8_SB(1, 1), cB + hstep + kstep, voffB);
        PG8_WAIT_V(6); PG8_BAR;
    } else {
        PG8_STAGE(PG8_SB(0, 0), cB, voffB); PG8_STAGE(PG8_SA(0, 0), cA, voffA); PG8_STAGE(PG8_SB(0, 1), cB + hstep, voffB); PG8_STAGE(PG8_SA(0, 1), cA + hstep, voffA);
        if (wr == 1) PG8_BAR;
        PG8_WAIT_V(4); PG8_BAR;
        PG8_STAGE(PG8_SB(1, 0), cB + kstep, voffB); PG8_STAGE(PG8_SA(1, 0), cA + kstep, voffA); PG8_STAGE(PG8_SB(1, 1), cB + hstep + kstep, voffB);
        PG8_WAIT_V(6); PG8_BAR;
    }
    for (;;) {
        const bool has_next = S.next(ui + 1, nxt);
        const char* nA = has_next ? (const char*)g.A + (size_t)nxt.pm * tstep : cA; const char* nB = has_next ? (const char*)g.Bt + (size_t)nxt.pn * tstep : cB;
        for (int t = 0; t < nt; t += 2) {
            const bool last = (t == nt - 2);
            const char* a1 = cA + (size_t)(t + 1) * kstep;
            const char* a2 = last ? nA : cA + (size_t)(t + 2) * kstep; const char* b2 = last ? nB : cB + (size_t)(t + 2) * kstep;
            const char* a3 = a2 + kstep; const char* b3 = b2 + kstep;
            if (last && has_next) S.a_ready(nxt);
            if constexpr (SP2) {
            PG8_LDB(B0, 0, 0); PG8_LDB(B1, 0, 1); PG8_SCHED; PG8_LDA(At, 0, 0); PG8_STAGE(PG8_SA(1, 1), a1 + hstep, voffA);
            PG8_WAIT_V(8); PG8_WAIT_L(0); PG8_BAR; PG8_MMA(0, 0, At, B0); PG8_MMA(0, 1, At, B1); PG8_BAR; PG8_SCHED;
            PG8_LDA(At, 0, 1); PG8_STAGE(PG8_SB(0, 0), b2, voffB); PG8_STAGE(PG8_SB(0, 1), b2 + hstep, voffB); PG8_STAGE(PG8_SA(0, 0), a2, voffA);
            PG8_WAIT_V(8); PG8_WAIT_L(0); PG8_BAR; PG8_MMA(1, 0, At, B0); PG8_MMA(1, 1, At, B1); PG8_BAR; PG8_SCHED;
            PG8_LDB(B0, 1, 0); PG8_LDB(B1, 1, 1); PG8_SCHED; PG8_LDA(At, 1, 0); PG8_STAGE(PG8_SA(0, 1), a2 + hstep, voffA);
            PG8_WAIT_V(8); PG8_WAIT_L(0); PG8_BAR; PG8_MMA(0, 0, At, B0); PG8_MMA(0, 1, At, B1); PG8_BAR; PG8_SCHED;
            PG8_LDA(At, 1, 1); PG8_STAGE(PG8_SB(1, 0), b3, voffB); PG8_STAGE(PG8_SB(1, 1), b3 + hstep, voffB); PG8_STAGE(PG8_SA(1, 0), a3, voffA);
            PG8_WAIT_V(8); PG8_WAIT_L(0); PG8_BAR; PG8_MMA(1, 0, At, B0); PG8_MMA(1, 1, At, B1); PG8_BAR; PG8_SCHED;
            } else {
            PG8_LDB(B0, 0, 0); PG8_SCHED; PG8_LDA(At, 0, 0); PG8_STAGE(PG8_SA(1, 1), a1 + hstep, voffA);
            PG8_WAIT_L(8); PG8_BAR; PG8_WAIT_L(0); PG8_MMA(0, 0, At, B0); PG8_BAR; PG8_SCHED;
            PG8_LDB(B1, 0, 1); PG8_STAGE(PG8_SB(0, 0), b2, voffB);
            PG8_BAR; PG8_WAIT_L(0); PG8_MMA(0, 1, At, B1); PG8_BAR;
            PG8_LDA(At, 0, 1); PG8_STAGE(PG8_SA(0, 0), a2, voffA);
            PG8_BAR; PG8_WAIT_L(0); PG8_MMA(1, 0, At, B0); PG8_BAR; PG8_SCHED;
            PG8_STAGE(PG8_SB(0, 1), b2 + hstep, voffB);
            PG8_WAIT_V(6); PG8_BAR; PG8_MMA(1, 1, At, B1); PG8_BAR;
            PG8_LDB(B0, 1, 0); PG8_SCHED; PG8_LDA(At, 1, 0); PG8_STAGE(PG8_SA(0, 1), a2 + hstep, voffA);
            PG8_WAIT_L(8); PG8_BAR; PG8_WAIT_L(0); PG8_MMA(0, 0, At, B0); PG8_BAR; PG8_SCHED;
            PG8_LDB(B1, 1, 1); PG8_STAGE(PG8_SB(1, 0), b3, voffB);
            PG8_BAR; PG8_WAIT_L(0); PG8_MMA(0, 1, At, B1); PG8_BAR;
            PG8_LDA(At, 1, 1); PG8_STAGE(PG8_SA(1, 0), a3, voffA);
            PG8_BAR; PG8_WAIT_L(0); PG8_MMA(1, 0, At, B0); PG8_BAR; PG8_SCHED;
            PG8_STAGE(PG8_SB(1, 1), b3 + hstep, voffB);
            PG8_WAIT_V(6); PG8_BAR; PG8_MMA(1, 1, At, B1); PG8_BAR;
            }
        }
        if constexpr (ALIGN_EPI) { if (wr == 0) PG8_BAR; }
        if constexpr (!Epi::AFTER_DRAIN) { E(acc, cur, wr, wc, fr, fq); S.done(cur); }
        if (!has_next) break;
#pragma unroll
        for (int a = 0; a < 2; ++a)
#pragma unroll
            for (int b = 0; b < 2; ++b)
#pragma unroll
                for (int m = 0; m < 4; ++m)
#pragma unroll
                    for (int n = 0; n < 2; ++n) acc[a][b][m][n] = (f32x4){0.f, 0.f, 0.f, 0.f};
        cur = nxt; cA = nA; cB = nB; ++ui;
        if constexpr (ALIGN_EPI) { if (wr == 1) PG8_BAR; }
    }
    PG8_WAIT_V(0);
    if constexpr (!ALIGN_EPI) { if (wr == 0) PG8_BAR; }
    PG8_BAR;
    if constexpr (Epi::AFTER_DRAIN) { E.fused(acc, cur, wr, wc, fr, fq, lds, wid, lane); S.done(cur); }
#undef PG8_SA
#undef PG8_SB
#undef PG8_STAGE
#undef PG8_LDA
#undef PG8_LDB
#undef PG8_MMA
#undef PG8_WAIT_V
#undef PG8_WAIT_L
#undef PG8_BAR
#undef PG8_SCHED
}
}
namespace pg8 {
struct EpiAbIn {
    static constexpr bool PERM = true, AFTER_DRAIN = false;
    bf16_t* R; bf16_t* P2; float* G;
    DI void operator()(const f32x4 (&acc)[2][2][4][2], const Unit& u, int wr, int wc, int fr, int fq) const {
        const int row0 = u.pm * BM + wr * 64 + fr;
#pragma unroll
        for (int ai = 0; ai < 2; ++ai)
#pragma unroll
            for (int m = 0; m < 4; ++m) { const size_t row = (size_t)(row0 + ai * HALF + m * 16);
#pragma unroll
                for (int bj = 0; bj < 2; ++bj) { const int cc = bj * HALF + wc * 32 + 8 * fq; const f32x4 v0 = acc[ai][bj][m][0], v1 = acc[ai][bj][m][1];
                    if (u.pn < 14) { u32x4 w; w.x = cvt_pk_bf16(v0[0], v0[1]); w.y = cvt_pk_bf16(v0[2], v0[3]); w.z = cvt_pk_bf16(v1[0], v1[1]); w.w = cvt_pk_bf16(v1[2], v1[3]);
                        if (u.pn < 6) *(u32x4*)(R + row * 1536 + u.pn * 256 + cc) = w; else *(u32x4*)(P2 + row * 2048 + (u.pn - 6) * 256 + cc) = w; }
                    else if (cc < 48) { *(f32x4*)(G + row * 64 + cc) = v0; *(f32x4*)(G + row * 64 + cc + 4) = v1; } } }
    }
};
struct EpiResid {
    static constexpr bool PERM = false, AFTER_DRAIN = false;
    float* out; const float* resid; const float* gate;
    DI void operator()(const f32x4 (&acc)[2][2][4][2], const Unit& u, int wr, int wc, int fr, int fq) const {
        const int row0 = u.pm * BM + wr * 64 + fr, col0 = u.pn * BM + wc * 32 + 4 * fq;
#pragma unroll
        for (int ai = 0; ai < 2; ++ai)
#pragma unroll
            for (int m = 0; m < 4; ++m) { const size_t row = (size_t)(row0 + ai * HALF + m * 16); const float* gp = gate + (row >> 13) * 6144;
#pragma unroll
                for (int bj = 0; bj < 2; ++bj)
#pragma unroll
                    for (int n = 0; n < 2; ++n) { const int col = col0 + bj * HALF + n * 16; const f32x4 g = *(const f32x4*)(gp + col); const f32x4 r = *(const f32x4*)(resid + row * 1024 + col);
                        *(f32x4*)(out + row * 1024 + col) = r + g * acc[ai][bj][m][n]; }
                asm volatile("" ::: "memory"); }
    }
};
struct EpiSwiglu {
    static constexpr bool PERM = false, AFTER_DRAIN = false;
    bf16_t* hid;
    DI void operator()(const f32x4 (&acc)[2][2][4][2], const Unit& u, int wr, int wc, int fr, int fq) const {
        const int row0 = u.pm * BM + wr * 64 + fr, col0 = u.pn * 128 + wc * 16 + 4 * fq;
#pragma unroll
        for (int ai = 0; ai < 2; ++ai)
#pragma unroll
            for (int m = 0; m < 4; ++m) { const size_t row = (size_t)(row0 + ai * HALF + m * 16);
#pragma unroll
                for (int bj = 0; bj < 2; ++bj) { const f32x4 a = acc[ai][bj][m][0], b = acc[ai][bj][m][1];
                    u32x2 w; w.x = cvt_pk_bf16(siluf(a[0]) * b[0], siluf(a[1]) * b[1]); w.y = cvt_pk_bf16(siluf(a[2]) * b[2], siluf(a[3]) * b[3]);
                    *(u32x2*)(hid + row * 2816 + col0 + bj * 64) = w; } }
    }
};
struct EpiBf16Plain {
    static constexpr bool PERM = true, AFTER_DRAIN = false;
    bf16_t* O; size_t ldc;
    DI void operator()(const f32x4 (&acc)[2][2][4][2], const Unit& u, int wr, int wc, int fr, int fq) const {
        const int row0 = u.pm * BM + wr * 64 + fr, col0 = u.pn * BM + wc * 32 + 8 * fq;
#pragma unroll
        for (int ai = 0; ai < 2; ++ai)
#pragma unroll
            for (int m = 0; m < 4; ++m) { bf16_t* rowp = O + (size_t)(row0 + ai * HALF + m * 16) * ldc + col0;
#pragma unroll
                for (int bj = 0; bj < 2; ++bj) { const f32x4 v0 = acc[ai][bj][m][0], v1 = acc[ai][bj][m][1];
                    u32x4 w; w.x = cvt_pk_bf16(v0[0], v0[1]); w.y = cvt_pk_bf16(v0[2], v0[3]); w.z = cvt_pk_bf16(v1[0], v1[1]); w.w = cvt_pk_bf16(v1[2], v1[3]);
                    *(u32x4*)(rowp + bj * HALF) = w; } }
    }
};
}
constexpr int T_LAT = 32768, T_CTX = 1024, T_ALL = 33792, DM = 1024, DFF = 2816, SEQ = 8192;
constexpr size_t MiB = 1048576;
constexpr size_t OFF_MODV = 0;
constexpr size_t OFF_W0 = MiB / 4;
constexpr size_t OFF_W0_ABIN = OFF_W0, OFF_W0_ABOUT = OFF_W0_ABIN + 3840ull * 1024 * 2, OFF_W0_F1 = OFF_W0_ABOUT + 1024ull * 1024 * 2, OFF_W0_F2 = OFF_W0_F1 + 5632ull * 1024 * 2;
constexpr size_t OFF_G = OFF_W0 + 26 * MiB;
constexpr size_t OFF_A = OFF_G + 8 * MiB + MiB / 4;
constexpr size_t OFF_R = OFF_A + 66 * MiB;
constexpr size_t OFF_P2 = OFF_R + 99 * MiB;
constexpr size_t OFF_PD = OFF_P2 + 132 * MiB;
constexpr size_t OFF_U0T = OFF_PD, OFF_KCD = OFF_U0T + 66 * MiB, OFF_ATT = OFF_KCD + 66 * MiB, OFF_GC = OFF_ATT + 33 * MiB;
constexpr size_t OFF_OGDN = OFF_A, OFF_OGLA = OFF_A + 64 * MiB;
constexpr size_t OFF_Y = OFF_PD;
constexpr size_t OFF_W1 = OFF_A + 450 * MiB;
constexpr size_t OFF_W1_HYIN = OFF_W1, OFF_W1_HYOUT = OFF_W1_HYIN + 3072ull * 1024 * 2, OFF_W1_F1 = OFF_W1_HYOUT + 1024ull * 1024 * 2, OFF_W1_F2 = OFF_W1_F1 + 5632ull * 1024 * 2;
constexpr size_t OFF_HID = OFF_R;
constexpr size_t OFF_UT = OFF_R;
constexpr size_t OFF_HT = OFF_R;
constexpr size_t OFF_SPEC = OFF_UT + 192 * MiB;
constexpr size_t OFF_ZT = OFF_SPEC + 128 * MiB;
constexpr size_t OFF_Z = OFF_A;
constexpr size_t OFF_HDN = 510 * MiB;
constexpr size_t WS_NEED = 512 * MiB;
static_assert(OFF_GC + 2 * MiB <= 512 * MiB && OFF_Y + 64 * MiB <= OFF_W1 && OFF_ZT + 64 * MiB <= OFF_W1 && WS_NEED <= 512 * MiB, "workspace map");
constexpr int LDS_BYTES = 147456;

struct Params {
    const float *x, *c, *ctx, *c_ctx, *mod_w, *mod_b, *norm1_w, *norm2_w, *ab_w_in, *ab_conv_w, *gdn_a_log, *gdn_dt_bias, *gdn_norm_w, *gla_gate_w, *gla_gate_b, *gla_norm_w, *ab_w_out,
        *hy_w_in, *hy_conv_w, *hy_pos_w1, *hy_pos_b1, *hy_pos_w2, *hy_pos_b2, *hy_pos_w3, *hy_pos_b3, *hy_freq, *hy_filt_out, *hy_skip, *hy_w_out, *ffn_w1, *ffn_w3, *ffn_w2, *final_norm_w;
    float* out; unsigned char* ws;
};

DI void conv_unit(bf16_t* dst, int K, int mode, const float* src, const float* src2, int ld, int rt, int kt) {
    int tid_ = threadIdx.x; asm volatile("" : "+v"(tid_)); const int tid = tid_, l = tid & 63, kq = tid >> 6, R = rt * 64 + l, k = kt * 64 + kq * 8;
    int col = R; const float* s = src;
    if (mode == 1) { col = R < 2048 ? R : (R < 3584 ? R + 16 : (R < 3600 ? 2048 + (R - 3584) : (R < 3632 ? R : -1))); }
    else if (mode == 2) { col = 128 * (R >> 8) + 64 * ((R >> 7) & 1) + 16 * ((R >> 5) & 3) + (R & 15); if ((R >> 4) & 1) s = src2; }
    float v[8];
#pragma unroll
    for (int i = 0; i < 8; ++i) v[i] = col >= 0 ? s[(size_t)(k + i) * ld + col] : 0.f;
    u32x4 w; w.x = cvt_pk_bf16(v[0], v[1]); w.y = cvt_pk_bf16(v[2], v[3]); w.z = cvt_pk_bf16(v[4], v[5]); w.w = cvt_pk_bf16(v[6], v[7]);
    *(u32x4*)(dst + (size_t)R * K + k) = w;
}
DI int conv_job(int base, bf16_t* dst, int K, int nrows, int mode, const float* src, const float* src2, int ld) {
    const int nrt = nrows / 64, nu = nrt * (K / 64);
    int g0 = (int)blockIdx.x - (base % (int)gridDim.x); if (g0 < 0) g0 += gridDim.x;
    for (int uu = g0; uu < nu; uu += gridDim.x) conv_unit(dst, K, mode, src, src2, ld, uu % nrt, uu / nrt);
    return base + nu;
}
DI void modvec_item(const Params& p, int item, float* lds) {
    int tid_ = threadIdx.x; asm volatile("" : "+v"(tid_)); const int tid = tid_, layer = item / 96, cg0 = (item % 96) * 64, c4 = (tid & 15) * 4, ks = tid >> 4;
    const float* W = p.mod_w + (size_t)layer * 1024 * 6144;
    f32x4 acc[5];
#pragma unroll
    for (int r = 0; r < 5; ++r) acc[r] = (f32x4){0.f, 0.f, 0.f, 0.f};
    for (int kk = 0; kk < 32; ++kk) { const int k = ks * 32 + kk; const f32x4 w = *(const f32x4*)(W + (size_t)k * 6144 + cg0 + c4);
#pragma unroll
        for (int r = 0; r < 5; ++r) { const float cv = r < 4 ? p.c[r * 1024 + k] : p.c_ctx[k]; acc[r] += w * siluf(cv); } }
#pragma unroll
    for (int r = 0; r < 5; ++r) *(f32x4*)(lds + ((ks * 5 + r) * 64 + c4)) = acc[r];
    __syncthreads();
    if (tid < 320) { const int r = tid >> 6, cc = tid & 63; float s = 0.f; for (int q = 0; q < 32; ++q) s += lds[(q * 5 + r) * 64 + cc];
        ((float*)(p.ws + OFF_MODV))[(size_t)(layer * 5 + r) * 6144 + cg0 + cc] = s + p.mod_b[layer * 6144 + cg0 + cc]; }
    __syncthreads();
}
DI void norm_phase(const float* lat, const float* ctxp, bf16_t* dst, int nrows, const float* gain, const float* modv, int sh_off, int sc_off) {
    const int lane = threadIdx.x & 63, wid = threadIdx.x >> 6;
    for (int r = blockIdx.x * 8 + wid; r < nrows; r += gridDim.x * 8) {
        const float* s = r < T_LAT ? lat + (size_t)r * DM : ctxp + (size_t)(r - T_LAT) * DM; const int mrow = r < T_LAT ? (r >> 13) : 4;
        f32x4 v[4]; float ss = 0.f;
#pragma unroll
        for (int i = 0; i < 4; ++i) { v[i] = __builtin_nontemporal_load((const f32x4*)(s + i * 256 + lane * 4)); ss += v[i][0] * v[i][0] + v[i][1] * v[i][1] + v[i][2] * v[i][2] + v[i][3] * v[i][3]; }
#pragma unroll
        for (int o = 32; o > 0; o >>= 1) ss += __shfl_xor(ss, o);
        const float rstd = rsqrtf(ss * (1.f / DM) + 1e-6f); const float* mv = modv + (size_t)mrow * 6144;
#pragma unroll
        for (int i = 0; i < 4; ++i) { const int col = i * 256 + lane * 4; const f32x4 g = *(const f32x4*)(gain + col), sh = *(const f32x4*)(mv + sh_off + col), sc = *(const f32x4*)(mv + sc_off + col);
            const f32x4 y = v[i] * rstd * g * (sc + 1.f) + sh; u32x2 w; w.x = cvt_pk_bf16(y[0], y[1]); w.y = cvt_pk_bf16(y[2], y[3]); *(u32x2*)(dst + (size_t)r * DM + col) = w; }
    }
}
DI void final_norm_phase(float* h, const float* gain) {
    const int lane = threadIdx.x & 63, wid = threadIdx.x >> 6;
    for (int r = blockIdx.x * 8 + wid; r < T_LAT; r += gridDim.x * 8) { float* s = h + (size_t)r * DM; f32x4 v[4]; float ss = 0.f;
#pragma unroll
        for (int i = 0; i < 4; ++i) { v[i] = __builtin_nontemporal_load((const f32x4*)(s + i * 256 + lane * 4)); ss += v[i][0] * v[i][0] + v[i][1] * v[i][1] + v[i][2] * v[i][2] + v[i][3] * v[i][3]; }
#pragma unroll
        for (int o = 32; o > 0; o >>= 1) ss += __shfl_xor(ss, o);
        const float rstd = rsqrtf(ss * (1.f / DM) + 1e-6f);
#pragma unroll
        for (int i = 0; i < 4; ++i) { const int col = i * 256 + lane * 4; __builtin_nontemporal_store(v[i] * rstd * *(const f32x4*)(gain + col), (f32x4*)(s + col)); } }
}
DI void copy_f32_phase(float* dst, const float* src, size_t n4) {
    for (size_t i = (size_t)blockIdx.x * blockDim.x + threadIdx.x; i < n4; i += (size_t)gridDim.x * blockDim.x) ((f32x4*)dst)[i] = ((const f32x4*)src)[i];
}
template <class Epi> DI void run_gemm(unsigned char* smem, const bf16_t* A, const bf16_t* Bt, int M, int N, int K, const Epi& E) {
    pg8::Gemm g{A, Bt, M, N, K}; pg8::StaticOrder S; S.init(M, N, gridDim.x, blockIdx.x);
    pg8::gemm_phase<Epi, pg8::StaticOrder, true, true>((PG8_LAS unsigned char*)smem, g, S, E);
}

#define XB_TMO      128
#define XB_XCNT(j)  (256  + 64 * (j))
#define XB_XSUB(j)  (1280 + 64 * (j))
#define XB_XGEN(j)  (2304 + 64 * (j))
#define XB_TOP      3328
#define XB_TOPGEN   3392
#define XCD_BAR_WORDS 3456
#define XB_SPIN_CAP (1u << 18)
#define LAS __attribute__((address_space(3)))

__device__ __forceinline__ unsigned xb_ld(unsigned* p)              { return __hip_atomic_load(p, __ATOMIC_RELAXED, __HIP_MEMORY_SCOPE_AGENT); }
__device__ __forceinline__ unsigned xb_add(unsigned* p, unsigned v) { return __hip_atomic_fetch_add(p, v, __ATOMIC_RELAXED, __HIP_MEMORY_SCOPE_AGENT); }
__device__ __forceinline__ unsigned xb_xcc_id() { return (unsigned)__builtin_amdgcn_s_getreg((3 << 11) | 20) & 0xFu; }
#define XB_SPIN(cond, bar) do { unsigned _sp = 0; while (cond) { __builtin_amdgcn_s_sleep(1); \
    if ((++_sp & 255u) == 0u) { if (xb_ld(&(bar)[XB_TMO])) break; if (_sp > XB_SPIN_CAP) { atomicAdd(&(bar)[XB_TMO], 1u); break; } } } } while (0)

struct XcdBarrier {
    unsigned* bar; unsigned x;
    volatile LAS unsigned* st;
};

__device__ __forceinline__ XcdBarrier xcd_barrier_post(unsigned* bar, volatile LAS unsigned* st) {
    XcdBarrier b; b.bar = bar; b.x = xb_xcc_id(); b.st = st;
    if (threadIdx.x == 0) (void)xb_add(&bar[XB_XCNT(b.x)], 1u);
    return b;
}
__device__ __forceinline__ void xcd_barrier_complete(unsigned* bar, unsigned x, unsigned& nloc, unsigned& nx) {
    const unsigned G = gridDim.x * gridDim.y * gridDim.z;
    unsigned sum, cnt, mine, sp = 0u;
    for (;;) {
        sum = 0u; cnt = 0u; mine = 0u;
#pragma unroll
        for (unsigned j = 0; j < 16; ++j) { const unsigned c = xb_ld(&bar[XB_XCNT(j)]); sum += c; cnt += (c > 0u) ? 1u : 0u; mine = (j == x) ? c : mine; }
        if (sum == G) break;
        __builtin_amdgcn_s_sleep(1);
        if ((++sp & 255u) == 0u) { if (xb_ld(&bar[XB_TMO])) break; if (sp > XB_SPIN_CAP) { atomicAdd(&bar[XB_TMO], 1u); break; } }
    }
    nloc = mine > 0u ? mine : 1u; nx = cnt > 0u ? cnt : 1u;
}

__device__ __forceinline__ void xcd_barrier(const XcdBarrier& b) {
    asm volatile("s_waitcnt vmcnt(0)" ::: "memory");
    __syncthreads();
    if (threadIdx.x == 0) {
        unsigned* bar = b.bar;
        __builtin_amdgcn_s_waitcnt(0);
        unsigned nloc = b.st[0], nx = b.st[1];
        if (nloc == 0u) { xcd_barrier_complete(bar, b.x, nloc, nx); b.st[0] = nloc; b.st[1] = nx; }
        const unsigned old = xb_add(&bar[XB_XSUB(b.x)], 1u);
        const unsigned gen = old / nloc;
        if (old + 1u == (gen + 1u) * nloc) {
            __builtin_amdgcn_fence(__ATOMIC_RELEASE, "agent");
            asm volatile("s_waitcnt vmcnt(0)" ::: "memory");
            const unsigned og = xb_add(&bar[XB_TOP], 1u);
            const unsigned tg = og / nx;
            if (og + 1u == (tg + 1u) * nx) xb_add(&bar[XB_TOPGEN], 1u);
            else XB_SPIN(xb_ld(&bar[XB_TOPGEN]) == tg, bar);
            __builtin_amdgcn_fence(__ATOMIC_ACQUIRE, "agent");
            xb_add(&bar[XB_XGEN(b.x)], 1u);
            asm volatile("s_waitcnt vmcnt(0)" ::: "memory");
        } else {
            XB_SPIN(xb_ld(&bar[XB_XGEN(b.x)]) == gen, bar);
            __builtin_amdgcn_fence(__ATOMIC_ACQUIRE, "agent");
            asm volatile("s_waitcnt vmcnt(0)" ::: "memory");
        }
    }
    __syncthreads();
}


constexpr size_t OFF_BAR = 245760;
constexpr int LDS_XB_ST = LDS_BYTES - 16;
DI f32x4 mfma16(bf16x8 a, bf16x8 b, f32x4 c) { return __builtin_amdgcn_mfma_f32_16x16x32_bf16(a, b, c, 0, 0, 0); }
DI bf16x8 ldsfrag(const unsigned char* base, int byteoff) { return *(const bf16x8*)(base + byteoff); }
DI size_t chunk_row0(int b, int j) { return j < 4 ? (size_t)T_LAT + b * 256 + j * 64 : (size_t)b * SEQ + (size_t)(j - 4) * 64; }
DI float softplusf_(float x) { return x > 20.f ? x : log1pf(__expf(x)); }
constexpr f32x4 Z4 = {0.f, 0.f, 0.f, 0.f};
DI void lds_barrier() { asm volatile("s_waitcnt lgkmcnt(0)" ::: "memory"); __builtin_amdgcn_s_barrier(); asm volatile("" ::: "memory"); }

constexpr int GP_Q = 0, GP_K = 17408, GP_KT = 34816, GP_VT = 53248, GP_X = 71680, GP_N = 108544, GP_GC = 141312;
DI void gdn_prep_item(const Params& p, unsigned char* smem, int item) {
    int tid_ = threadIdx.x; asm volatile("" : "+v"(tid_)); const int tid = tid_, lane = tid & 63, wid = tid >> 6, fr = lane & 15, fq = lane >> 4;
    const int h = item & 3, j = (item >> 2) % 132, b = item / 528;
    const size_t row0 = chunk_row0(b, j);
    unsigned char* ws = p.ws;
    const bf16_t* R = (const bf16_t*)(ws + OFF_R); const float* G = (const float*)(ws + OFF_G);
    bf16_t* QH = (bf16_t*)p.out + (size_t)item * 8192; bf16_t* KT = (bf16_t*)p.out + (size_t)2112 * 8192 + (size_t)item * 8192;
    float* gc_s = (float*)(smem + GP_GC); float* beta_s = gc_s + 128;
    { const int c = tid >> 3, g8 = tid & 7, col0 = g8 * 16;
      const bool hasp = !(c == 0 && (j == 0 || j == 4)), hasn = !(c == 63 && (j == 3 || j == 131));
#pragma unroll
      for (int t = 0; t < 3; ++t) {
          const int gc0 = t * 512 + h * 128 + col0; const bf16_t* rp = R + (row0 + c) * 1536 + gc0;
          u32x4 xm[2], x0[2], xp[2];
#pragma unroll
          for (int q = 0; q < 2; ++q) { x0[q] = *(const u32x4*)(rp + q * 8); xm[q] = hasp ? *(const u32x4*)(rp - 1536 + q * 8) : (u32x4){0u, 0u, 0u, 0u}; xp[q] = hasn ? *(const u32x4*)(rp + 1536 + q * 8) : (u32x4){0u, 0u, 0u, 0u}; }
          f32x4 wv[3][4];
#pragma unroll
          for (int jj = 0; jj < 3; ++jj)
#pragma unroll
              for (int k4 = 0; k4 < 4; ++k4) wv[jj][k4] = *(const f32x4*)(p.ab_conv_w + jj * 1536 + gc0 + 4 * k4);
          float o[16]; float ss = 0.f;
#pragma unroll
          for (int q = 0; q < 2; ++q)
#pragma unroll
              for (int e = 0; e < 4; ++e) { const int ci = q * 8 + e * 2;
                  float a0 = wv[0][ci >> 2][ci & 3] * bflo(xm[q][e]) + wv[1][ci >> 2][ci & 3] * bflo(x0[q][e]) + wv[2][ci >> 2][ci & 3] * bflo(xp[q][e]);
                  float a1 = wv[0][ci >> 2][(ci & 3) + 1] * bfhi(xm[q][e]) + wv[1][ci >> 2][(ci & 3) + 1] * bfhi(x0[q][e]) + wv[2][ci >> 2][(ci & 3) + 1] * bfhi(xp[q][e]);
                  a0 = siluf(a0); a1 = siluf(a1); o[ci] = a0; o[ci + 1] = a1; ss += a0 * a0 + a1 * a1; }
          if (t < 2) { ss += __shfl_xor(ss, 1); ss += __shfl_xor(ss, 2); ss += __shfl_xor(ss, 4); const float sc = rsqrtf(ss + 1e-6f) * (t == 0 ? 0.08838834764831845f : 1.f);
#pragma unroll
              for (int e = 0; e < 16; ++e) o[e] *= sc; }
          u32x4 w0, w1; w0.x = cvt_pk_bf16(o[0], o[1]); w0.y = cvt_pk_bf16(o[2], o[3]); w0.z = cvt_pk_bf16(o[4], o[5]); w0.w = cvt_pk_bf16(o[6], o[7]);
          w1.x = cvt_pk_bf16(o[8], o[9]); w1.y = cvt_pk_bf16(o[10], o[11]); w1.z = cvt_pk_bf16(o[12], o[13]); w1.w = cvt_pk_bf16(o[14], o[15]);
          if (t == 0) { *(u32x4*)(smem + GP_Q + c * 272 + col0 * 2) = w0; *(u32x4*)(smem + GP_Q + c * 272 + col0 * 2 + 16) = w1; *(u32x4*)(QH + c * 128 + col0) = w0; *(u32x4*)(QH + c * 128 + col0 + 8) = w1; }
          else if (t == 1) { *(u32x4*)(smem + GP_K + c * 272 + col0 * 2) = w0; *(u32x4*)(smem + GP_K + c * 272 + col0 * 2 + 16) = w1;
#pragma unroll
              for (int e = 0; e < 16; ++e) *(bf16_t*)(smem + GP_KT + (col0 + e) * 144 + c * 2) = f2bf(o[e]); }
          else {
#pragma unroll
              for (int e = 0; e < 16; ++e) *(bf16_t*)(smem + GP_VT + (col0 + e) * 144 + c * 2) = f2bf(o[e]); }
      }
      if (tid < 128) { const int dir = tid >> 6, cc = tid & 63; const float* gr = G + (row0 + cc) * 64;
          float g = -__expf(p.gdn_a_log[dir * 4 + h]) * softplusf_(gr[dir * 4 + h] + p.gdn_dt_bias[dir * 4 + h]); const float be = sigmoidf_(gr[8 + dir * 4 + h]);
          if (dir == 0) {
#pragma unroll
              for (int o = 1; o < 64; o <<= 1) { const float t = __shfl_up(g, o); if (lane >= o) g += t; } }
          else {
#pragma unroll
              for (int o = 1; o < 64; o <<= 1) { const float t = __shfl_down(g, o); if (lane + o < 64) g += t; } }
          gc_s[dir * 64 + cc] = g; beta_s[dir * 64 + cc] = be;
          ((float*)(ws + OFF_GC))[((size_t)item * 2 + dir) * 64 + cc] = g; }
    }
    __syncthreads();
    { float* kk_s = (float*)(smem + GP_X); float* qk_s = kk_s + 4096;
#pragma unroll
      for (int tt = 0; tt < 2; ++tt) { const int tile = wid * 2 + tt, mt = tile >> 2, nt = tile & 3; f32x4 ak = Z4, aq = Z4;
#pragma unroll
          for (int ks = 0; ks < 4; ++ks) { const int co = (32 * ks + 8 * fq) * 2; const bf16x8 bk = ldsfrag(smem, GP_K + (16 * nt + fr) * 272 + co);
              ak = mfma16(ldsfrag(smem, GP_K + (16 * mt + fr) * 272 + co), bk, ak); aq = mfma16(ldsfrag(smem, GP_Q + (16 * mt + fr) * 272 + co), bk, aq); }
#pragma unroll
          for (int r = 0; r < 4; ++r) { kk_s[(16 * mt + 4 * fq + r) * 64 + 16 * nt + fr] = ak[r]; qk_s[(16 * mt + 4 * fq + r) * 64 + 16 * nt + fr] = aq[r]; } }
      const int d = tid >> 2, part = tid & 3;
      *(u32x4*)(KT + d * 64 + part * 16) = *(const u32x4*)(smem + GP_KT + d * 144 + part * 32); *(u32x4*)(KT + d * 64 + part * 16 + 8) = *(const u32x4*)(smem + GP_KT + d * 144 + part * 32 + 16);
    }
    __syncthreads();
    { const float* kk_s = (const float*)(smem + GP_X); const float* qk_s = kk_s + 4096; float* N_s = (float*)(smem + GP_N);
#pragma unroll
      for (int q = 0; q < 2; ++q) { const int pc = tid + 512 * q, dir = pc >> 9, ip = (pc >> 3) & 63, g8 = pc & 7, i = dir ? 63 - ip : ip, base = dir ? 56 - 8 * g8 : 8 * g8;
          const f32x4 k0 = *(const f32x4*)(kk_s + i * 64 + base), k1 = *(const f32x4*)(kk_s + i * 64 + base + 4), c0 = *(const f32x4*)(gc_s + dir * 64 + base), c1 = *(const f32x4*)(gc_s + dir * 64 + base + 4);
          const float bi = beta_s[dir * 64 + i], gi = gc_s[dir * 64 + i]; float v[8];
#pragma unroll
          for (int e = 0; e < 8; ++e) { const int se = dir ? 7 - e : e; const float kv = se < 4 ? k0[se & 3] : k1[se & 3], cv = se < 4 ? c0[se & 3] : c1[se & 3]; v[e] = (8 * g8 + e) < ip ? bi * kv * __expf(gi - cv) : 0.f; }
          *(f32x4*)(N_s + dir * 4096 + ip * 64 + 8 * g8) = (f32x4){v[0], v[1], v[2], v[3]}; *(f32x4*)(N_s + dir * 4096 + ip * 64 + 8 * g8 + 4) = (f32x4){v[4], v[5], v[6], v[7]}; }
#pragma unroll
      for (int q = 0; q < 2; ++q) { const int pc = tid + 512 * q, dir = pc >> 9, i = (pc >> 3) & 63, j8 = pc & 7; float v[8];
#pragma unroll
          for (int e = 0; e < 8; ++e) { const int jj = j8 * 8 + e; const bool keep = dir ? (jj >= i) : (jj <= i); v[e] = keep ? qk_s[i * 64 + jj] * __expf(gc_s[dir * 64 + i] - gc_s[dir * 64 + jj]) : 0.f; }
          u32x4 w; w.x = cvt_pk_bf16(v[0], v[1]); w.y = cvt_pk_bf16(v[2], v[3]); w.z = cvt_pk_bf16(v[4], v[5]); w.w = cvt_pk_bf16(v[6], v[7]);
          *(u32x4*)((bf16_t*)(ws + OFF_ATT) + ((size_t)item * 2 + dir) * 4096 + i * 64 + j8 * 8) = w; }
    }
    __syncthreads();
    { const int SCR = GP_Q; float Tc[32];
      if (wid < 4) { const int dir = wid >> 1, blkB = wid & 1; const int r0 = blkB * 32, jl = lane & 31;
          const float* Nb = (const float*)(smem + GP_N) + dir * 4096 + r0 * 65;
          const int jp = r0 + jl, jo = dir ? 63 - jp : jp; const float bj = beta_s[dir * 64 + jo], bej = bj * __expf(gc_s[dir * 64 + jo]);
          const int st = dir ? -72 : 72;
          bf16_t* p1 = (bf16_t*)(smem + GP_X) + dir * 4608 + (dir ? 63 - r0 : r0) * 72 + jo; bf16_t* p2 = p1 + 9216;
          bf16_t* z1 = (bf16_t*)(smem + GP_X) + dir * 4608 + (dir ? 63 : 0) * 72 + jo;
          bf16_t* tp = (bf16_t*)(smem + SCR + dir * 10240 + (blkB ? 5120 + jl * 2 : jl * 80));
          const int tps = blkB ? 40 : 1;
#pragma unroll
          for (int il = 0; il < 32; ++il) { float a = (jl == il) ? 1.f : 0.f;
#pragma unroll
              for (int kl = 0; kl < il; ++kl) a -= Nb[il * 64 + kl] * Tc[kl];
              Tc[il] = a;
              p1[0] = f2bf(a * bj); p2[0] = f2bf(a * bej); tp[0] = f2bf(a);
              if (blkB) { z1[0] = 0; z1[9216] = 0; }
              p1 += st; p2 += st; z1 += st; tp += tps; asm volatile("" ::: "memory"); } }
      else {
          const int t2 = tid - 256;
#pragma unroll
          for (int q = 0; q < 8; ++q) { const int e2 = t2 + 256 * q, dir = e2 >> 10, il = (e2 >> 5) & 31, kl = e2 & 31;
              *(bf16_t*)(smem + SCR + dir * 10240 + 2560 + il * 80 + kl * 2) = f2bf(((const float*)(smem + GP_N))[dir * 4096 + (32 + il) * 64 + kl]); } }
    }
    __syncthreads();
    if (wid < 2) { const int dir = wid; const int SCR = GP_Q + dir * 10240;
        f32x4 x[2][2];
#pragma unroll
        for (int mt = 0; mt < 2; ++mt)
#pragma unroll
            for (int nt = 0; nt < 2; ++nt) x[mt][nt] = mfma16(ldsfrag(smem, SCR + 2560 + (16 * mt + fr) * 80 + fq * 16), ldsfrag(smem, SCR + (16 * nt + fr) * 80 + fq * 16), Z4);
#pragma unroll
        for (int mt = 0; mt < 2; ++mt)
#pragma unroll
            for (int nt = 0; nt < 2; ++nt) { u32x2 w; w.x = cvt_pk_bf16(x[mt][nt][0], x[mt][nt][1]); w.y = cvt_pk_bf16(x[mt][nt][2], x[mt][nt][3]); *(u32x2*)(smem + SCR + 7680 + (16 * nt + fr) * 80 + (16 * mt + 4 * fq) * 2) = w; }
        bf16_t* A1 = (bf16_t*)(smem + GP_X) + dir * 4608; bf16_t* A2 = (bf16_t*)(smem + GP_X + 18432) + dir * 4608;
#pragma unroll
        for (int mt = 0; mt < 2; ++mt)
#pragma unroll
            for (int nt = 0; nt < 2; ++nt) { const f32x4 t = mfma16(ldsfrag(smem, SCR + 5120 + (16 * mt + fr) * 80 + fq * 16), ldsfrag(smem, SCR + 7680 + (16 * nt + fr) * 80 + fq * 16), Z4);
                const int jp = 16 * nt + fr, jo = dir ? 63 - jp : jp; const float bj = beta_s[dir * 64 + jo], bej = bj * __expf(gc_s[dir * 64 + jo]);
#pragma unroll
                for (int r = 0; r < 4; ++r) { const int ip = 32 + 16 * mt + 4 * fq + r, io = dir ? 63 - ip : ip; A1[io * 72 + jo] = f2bf(-t[r] * bj); A2[io * 72 + jo] = f2bf(-t[r] * bej); } }
    }
    __syncthreads();
    { const int dir = wid >> 2; const size_t pd = (size_t)item * 2 + dir; bf16_t* U0T = (bf16_t*)(ws + OFF_U0T) + pd * 8192; bf16_t* KCD = (bf16_t*)(ws + OFF_KCD) + pd * 8192;
      const int A1o = GP_X + dir * 9216, A2o = GP_X + 18432 + dir * 9216;
#pragma unroll
      for (int tt = 0; tt < 8; ++tt) { const int tile = (wid & 3) * 8 + tt; f32x4 au = Z4, ak = Z4;
          { const int mt = tile >> 3, nt = tile & 7;
#pragma unroll
            for (int ks = 0; ks < 2; ++ks) { const int co = (32 * ks + 8 * fq) * 2; au = mfma16(ldsfrag(smem, A1o + (16 * mt + fr) * 144 + co), ldsfrag(smem, GP_VT + (16 * nt + fr) * 144 + co), au); }
            u32x2 w; w.x = cvt_pk_bf16(au[0], au[1]); w.y = cvt_pk_bf16(au[2], au[3]); *(u32x2*)(U0T + (16 * nt + fr) * 64 + 16 * mt + 4 * fq) = w; }
          { const int md = tile >> 2, ni = tile & 3;
#pragma unroll
            for (int ks = 0; ks < 2; ++ks) { const int co = (32 * ks + 8 * fq) * 2; ak = mfma16(ldsfrag(smem, GP_KT + (16 * md + fr) * 144 + co), ldsfrag(smem, A2o + (16 * ni + fr) * 144 + co), ak); }
            u32x2 w; w.x = cvt_pk_bf16(ak[0], ak[1]); w.y = cvt_pk_bf16(ak[2], ak[3]); *(u32x2*)(KCD + (16 * ni + fr) * 128 + 16 * md + 4 * fq) = w; } }
    }
    __syncthreads();
}
constexpr int GS_KCD = 0, GS_QD = 17408, GS_KDT = 34816, GS_ATT = 53248, GS_ST = 62464, GS_UT = 97280;
DI void gdn_scan_chain(const Params& p, unsigned char* smem, int cid, int half) {
    const int tid = threadIdx.x, lane = tid & 63, wid = tid >> 6, fr = lane & 15, fq = lane >> 4;
    const int b = cid >> 3, h = (cid >> 1) & 3, dir = cid & 1;
    unsigned char* ws = p.ws;
    const bf16_t* QHg = (const bf16_t*)p.out; const bf16_t* KTg = (const bf16_t*)p.out + (size_t)2112 * 8192;
    bf16_t* OG = (bf16_t*)(ws + OFF_OGDN) + (size_t)dir * T_LAT * 512;
    const int cw = wid & 1, ecol0 = half * 32 + 16 * cw;
    const int STo = GS_ST + cw * 4352, UTo = GS_UT + cw * 2304;
    f32x4 S[8];
#pragma unroll
    for (int i = 0; i < 8; ++i) S[i] = Z4;
    if (wid < 2) for (int i = lane; i < 4352 / 16; i += 64) *(u32x4*)(smem + STo + i * 16) = (u32x4){0u, 0u, 0u, 0u};
    struct Pf { u32x4 rk[2], rq[2], rt[2], ra; u32x2 ru[4]; float gq[2]; f32x4 gk[2][2]; float gend; };
    Pf pfA, pfB;
#define GDN_PREFETCH(PF, jn) do { const int item_ = (b * 132 + (jn)) * 4 + h; const size_t pd_ = (size_t)item_ * 2 + dir; \
        const bf16_t* kcd_ = (const bf16_t*)(ws + OFF_KCD) + pd_ * 8192; const bf16_t* att_ = (const bf16_t*)(ws + OFF_ATT) + pd_ * 4096; const bf16_t* u0_ = (const bf16_t*)(ws + OFF_U0T) + pd_ * 8192; \
        const float* gc_ = (const float*)(ws + OFF_GC) + pd_ * 64; const bf16_t* qh_ = QHg + (size_t)item_ * 8192; const bf16_t* kt_ = KTg + (size_t)item_ * 8192; \
        _Pragma("unroll") for (int q_ = 0; q_ < 2; ++q_) { const int pid_ = tid + 512 * q_; (PF).rk[q_] = *(const u32x4*)(kcd_ + (pid_ >> 4) * 128 + (pid_ & 15) * 8); (PF).rq[q_] = *(const u32x4*)(qh_ + (pid_ >> 4) * 128 + (pid_ & 15) * 8); (PF).gq[q_] = gc_[pid_ >> 4]; \
            (PF).rt[q_] = *(const u32x4*)(kt_ + (pid_ >> 3) * 64 + (pid_ & 7) * 8); (PF).gk[q_][0] = *(const f32x4*)(gc_ + (pid_ & 7) * 8); (PF).gk[q_][1] = *(const f32x4*)(gc_ + (pid_ & 7) * 8 + 4); } \
        (PF).ra = *(const u32x4*)(att_ + (tid >> 3) * 64 + (tid & 7) * 8); (PF).gend = gc_[dir ? 0 : 63]; \
        _Pragma("unroll") for (int mt_ = 0; mt_ < 4; ++mt_) (PF).ru[mt_] = *(const u32x2*)(u0_ + (ecol0 + fr) * 64 + 16 * mt_ + 4 * fq); } while (0)
    GDN_PREFETCH(pfA, dir ? 3 : 0); GDN_PREFETCH(pfB, dir ? 2 : 1);
    unsigned pfv = 0u, pfacc = 0u;
#define GDN_WARM(jn) do { const int item_ = (b * 132 + (jn)) * 4 + h; const size_t pd_ = (size_t)item_ * 2 + dir; const bf16_t* a_; \
        if (tid < 128) a_ = (const bf16_t*)(ws + OFF_KCD) + pd_ * 8192 + tid * 64; else if (tid < 256) a_ = QHg + (size_t)item_ * 8192 + (tid - 128) * 64; \
        else if (tid < 384) a_ = KTg + (size_t)item_ * 8192 + (tid - 256) * 64; else if (tid < 448) a_ = (const bf16_t*)(ws + OFF_ATT) + pd_ * 4096 + (tid - 384) * 64; \
        else a_ = (const bf16_t*)(ws + OFF_U0T) + pd_ * 8192 + half * 4096 + (tid - 448) * 64; \
        pfv = *(const unsigned*)a_; } while (0)
    auto step = [&](Pf& pf, const int s) __attribute__((always_inline)) {
        const int j = dir ? (s < 4 ? 3 - s : 135 - s) : s;
        const float gl = __expf(pf.gend);
#pragma unroll
        for (int q = 0; q < 2; ++q) { const int pid = tid + 512 * q;
            *(u32x4*)(smem + GS_KCD + (pid >> 4) * 272 + (pid & 15) * 16) = pf.rk[q];
            { const float sc = __expf(pf.gq[q]); u32x4 w;
#pragma unroll
              for (int e = 0; e < 4; ++e) w[e] = cvt_pk_bf16(bflo(pf.rq[q][e]) * sc, bfhi(pf.rq[q][e]) * sc);
              *(u32x4*)(smem + GS_QD + (pid >> 4) * 272 + (pid & 15) * 16) = w; }
            { u32x4 w;
#pragma unroll
              for (int e = 0; e < 4; ++e) { const float s0 = __expf(pf.gend - pf.gk[q][e >> 1][(e & 1) * 2]), s1 = __expf(pf.gend - pf.gk[q][e >> 1][(e & 1) * 2 + 1]); w[e] = cvt_pk_bf16(bflo(pf.rt[q][e]) * s0, bfhi(pf.rt[q][e]) * s1); }
              *(u32x4*)(smem + GS_KDT + (pid >> 3) * 144 + (pid & 7) * 16) = w; } }
        *(u32x4*)(smem + GS_ATT + (tid >> 3) * 144 + (tid & 7) * 16) = pf.ra;
        f32x4 u[4];
#pragma unroll
        for (int mt = 0; mt < 4; ++mt) u[mt] = (f32x4){bflo(pf.ru[mt].x), bfhi(pf.ru[mt].x), bflo(pf.ru[mt].y), bfhi(pf.ru[mt].y)};
        lds_barrier();
        if (s + 2 < 132) { const int jn = dir ? (s + 2 < 4 ? 3 - (s + 2) : 135 - (s + 2)) : s + 2; GDN_PREFETCH(pf, jn); }
        if (wid < 2) {
        __builtin_amdgcn_s_setprio(2);
        bf16x8 sb[4];
#pragma unroll
        for (int ks = 0; ks < 4; ++ks) sb[ks] = ldsfrag(smem, STo + fr * 272 + (32 * ks + 8 * fq) * 2);
#pragma unroll
        for (int mt = 0; mt < 4; ++mt) { f32x4 pacc = Z4;
#pragma unroll
            for (int ks = 0; ks < 4; ++ks) pacc = mfma16(ldsfrag(smem, GS_KCD + (16 * mt + fr) * 272 + (32 * ks + 8 * fq) * 2), sb[ks], pacc);
            u[mt] -= pacc;
            u32x2 w; w.x = cvt_pk_bf16(u[mt][0], u[mt][1]); w.y = cvt_pk_bf16(u[mt][2], u[mt][3]); *(u32x2*)(smem + UTo + fr * 144 + (16 * mt + 4 * fq) * 2) = w; }
        bf16x8 ub[2];
#pragma unroll
        for (int ks = 0; ks < 2; ++ks) ub[ks] = ldsfrag(smem, UTo + fr * 144 + (32 * ks + 8 * fq) * 2);
        if (j >= 4) { const size_t row0 = (size_t)b * SEQ + (size_t)(j - 4) * 64;
#pragma unroll
            for (int mt = 0; mt < 4; ++mt) { f32x4 o = Z4;
#pragma unroll
                for (int ks = 0; ks < 4; ++ks) o = mfma16(ldsfrag(smem, GS_QD + (16 * mt + fr) * 272 + (32 * ks + 8 * fq) * 2), sb[ks], o);
#pragma unroll
                for (int ks = 0; ks < 2; ++ks) o = mfma16(ldsfrag(smem, GS_ATT + (16 * mt + fr) * 144 + (32 * ks + 8 * fq) * 2), ub[ks], o);
#pragma unroll
                for (int r = 0; r < 4; ++r) OG[(row0 + 16 * mt + 4 * fq + r) * 512 + h * 128 + ecol0 + fr] = f2bf(o[r]); } }
#pragma unroll
        for (int md = 0; md < 8; ++md) { f32x4 a = S[md] * gl;
#pragma unroll
            for (int ks = 0; ks < 2; ++ks) a = mfma16(ldsfrag(smem, GS_KDT + (16 * md + fr) * 144 + (32 * ks + 8 * fq) * 2), ub[ks], a);
            S[md] = a;
            u32x2 w; w.x = cvt_pk_bf16(a[0], a[1]); w.y = cvt_pk_bf16(a[2], a[3]); *(u32x2*)(smem + STo + fr * 272 + (16 * md + 4 * fq) * 2) = w; }
        __builtin_amdgcn_s_setprio(0);
        }
        lds_barrier();
    };
    for (int s2 = 0; s2 < 132; s2 += 2) { step(pfA, s2); step(pfB, s2 + 1); }
#undef GDN_PREFETCH
#undef GDN_WARM
    asm volatile("" :: "v"(pfacc));
}
constexpr size_t OFF_GKDT = OFF_A + 128 * MiB;
constexpr size_t OFF_GGL = OFF_GC + 2 * MiB;
constexpr size_t DOUT_GQD = (size_t)2 * 2112 * 8192;
static_assert(OFF_GKDT + 33 * MiB <= OFF_P2 && OFF_GGL + 2 * MiB <= 512 * MiB, "gla map");
constexpr int GL_LLR = 0, GL_Q = 4096, GL_K = 13312, GL_QD = 22528, GL_QT = 31744, GL_KTL = 40960, GL_KDT = 50176, GL_VT = 59392, GL_ATT = 77824, GL_SEG = 87040, GL_END = 89088;
DI void gla_pre_phase(const Params& p, unsigned char* smem) {
    int tid_ = threadIdx.x; asm volatile("" : "+v"(tid_)); const int tid = tid_, lane = tid & 63, wid = tid >> 6, fr = lane & 15, fq = lane >> 4;
    unsigned char* ws = p.ws;
    const bf16_t* P2 = (const bf16_t*)(ws + OFF_P2); const float* G = (const float*)(ws + OFF_G);
    const int dcol = tid & 63, seg = tid >> 6;
    float gw[16]; float gbias = 0.f; int gcode = -1;
    u32x4 nq, nk, nv[2]; f32x4 nl = Z4;
#define GLAPRE_LOAD(it_) do { const int dir_ = (it_) & 1, h_ = ((it_) >> 1) & 3, j_ = ((it_) >> 3) % 132, b_ = (it_) / 1056; const size_t r0_ = chunk_row0(b_, j_); \
        const bf16_t* pr_ = P2 + (r0_ + (tid >> 3)) * 2048 + (tid & 7) * 8; nq = *(const u32x4*)(pr_ + 512 + h_ * 64); nk = *(const u32x4*)(pr_ + 768 + h_ * 64); \
        _Pragma("unroll") for (int q_ = 0; q_ < 2; ++q_) { const int pid_ = tid + 512 * q_; nv[q_] = *(const u32x4*)(P2 + (r0_ + (pid_ & 63)) * 2048 + 1024 + h_ * 128 + (pid_ >> 6) * 8); } \
        if (tid < 256) nl = *(const f32x4*)(G + (r0_ + (tid >> 2)) * 64 + 16 + dir_ * 16 + (tid & 3) * 4); } while (0)
    if ((int)blockIdx.x < 4224) GLAPRE_LOAD((int)blockIdx.x);
    for (int item = blockIdx.x; item < 4224; item += gridDim.x) {
    const int dir = item & 1, h = (item >> 1) & 3, j = (item >> 3) % 132, b = item / 1056;
    if ((item & 7) != gcode) { gcode = item & 7;
#pragma unroll
        for (int r = 0; r < 16; ++r) gw[r] = p.gla_gate_w[(dir * 16 + r) * 256 + h * 64 + dcol];
        gbias = p.gla_gate_b[dir * 256 + h * 64 + dcol]; }
    { *(u32x4*)(smem + GL_Q + (tid >> 3) * 144 + (tid & 7) * 16) = nq; *(u32x4*)(smem + GL_K + (tid >> 3) * 144 + (tid & 7) * 16) = nk;
#pragma unroll
      for (int q = 0; q < 2; ++q) { const int pid = tid + 512 * q, c = pid & 63, e0 = (pid >> 6) * 8;
#pragma unroll
          for (int e = 0; e < 4; ++e) { *(bf16_t*)(smem + GL_VT + (e0 + 2 * e) * 144 + c * 2) = (bf16_t)(nv[q][e] & 0xffffu); *(bf16_t*)(smem + GL_VT + (e0 + 2 * e + 1) * 144 + c * 2) = (bf16_t)(nv[q][e] >> 16); } }
      if (tid < 256) *(f32x4*)(smem + GL_LLR + (tid >> 2) * 64 + (tid & 3) * 16) = nl;
      if (item + (int)gridDim.x < 4224) GLAPRE_LOAD(item + (int)gridDim.x); }
    lds_barrier();
    float inc[8]; float tot8 = 0.f;
    { float la[8];
#pragma unroll
      for (int i = 0; i < 8; ++i) { const f32x4* lr = (const f32x4*)(smem + GL_LLR + (seg * 8 + i) * 64); float g = gbias;
#pragma unroll
          for (int r4 = 0; r4 < 4; ++r4) { const f32x4 l4 = lr[r4];
#pragma unroll
              for (int r = 0; r < 4; ++r) g += l4[r] * gw[r4 * 4 + r]; }
          la[i] = (fminf(g, 0.f) - log1pf(__expf(-fabsf(g)))) * (1.f / 16.f); }
      if (dir == 0) {
#pragma unroll
          for (int i = 0; i < 8; ++i) { tot8 += la[i]; inc[i] = tot8; } }
      else {
#pragma unroll
          for (int i = 7; i >= 0; --i) { tot8 += la[i]; inc[i] = tot8; } } }
    ((float*)(smem + GL_SEG))[seg * 64 + dcol] = tot8;
    lds_barrier();
    { float off = 0.f, tot = 0.f, ref = 0.f;
#pragma unroll
      for (int sg = 0; sg < 8; ++sg) { const float v = ((const float*)(smem + GL_SEG))[sg * 64 + dcol]; tot += v; if (dir == 0 ? sg < seg : sg > seg) off += v; if (dir == 0 ? sg < 4 : sg >= 4) ref += v; }
      u32x4 kdw;
#pragma unroll
      for (int i = 0; i < 8; i += 2) { float kdv[2];
#pragma unroll
          for (int ii = 0; ii < 2; ++ii) { const int c = seg * 8 + i + ii; const float bc = off + inc[i + ii];
              const float qv = bf2f(*(const bf16_t*)(smem + GL_Q + c * 144 + dcol * 2)) * 0.125f, kv = bf2f(*(const bf16_t*)(smem + GL_K + c * 144 + dcol * 2));
              *(bf16_t*)(smem + GL_QD + c * 144 + dcol * 2) = f2bf(qv * __expf(bc)); *(bf16_t*)(smem + GL_QT + c * 144 + dcol * 2) = f2bf(qv * __expf(bc - ref));
              *(bf16_t*)(smem + GL_KTL + c * 144 + dcol * 2) = f2bf(kv * __expf(ref - bc)); kdv[ii] = kv * __expf(tot - bc); }
          kdw[i >> 1] = cvt_pk_bf16(kdv[0], kdv[1]); }
      *(u32x4*)((bf16_t*)(ws + OFF_GKDT) + (size_t)item * 4096 + dcol * 64 + seg * 8) = kdw;
      if (seg == 0) ((float*)(ws + OFF_GGL))[(size_t)item * 64 + dcol] = __expf(tot); }
    lds_barrier();
    if (j >= 4) {
        { const int lit = ((b * 128 + (j - 4)) * 4 + h) * 2 + dir;
          *(u32x4*)((bf16_t*)p.out + DOUT_GQD + (size_t)lit * 4096 + (tid >> 3) * 64 + (tid & 7) * 8) = *(const u32x4*)(smem + GL_QD + (tid >> 3) * 144 + (tid & 7) * 16); }
#pragma unroll
        for (int tt = 0; tt < 2; ++tt) { const int tile = wid * 2 + tt, st = tile >> 2, ct = tile & 3; f32x4 a = Z4;
#pragma unroll
            for (int ks = 0; ks < 2; ++ks) { const int co = (32 * ks + 8 * fq) * 2; a = mfma16(ldsfrag(smem, GL_KTL + (16 * st + fr) * 144 + co), ldsfrag(smem, GL_QT + (16 * ct + fr) * 144 + co), a); }
            const int c = 16 * ct + fr; float v[4];
#pragma unroll
            for (int r = 0; r < 4; ++r) { const int sidx = 16 * st + 4 * fq + r; v[r] = (dir ? sidx >= c : sidx <= c) ? a[r] : 0.f; }
            u32x2 w; w.x = cvt_pk_bf16(v[0], v[1]); w.y = cvt_pk_bf16(v[2], v[3]); *(u32x2*)(smem + GL_ATT + c * 144 + (16 * st + 4 * fq) * 2) = w; }
        lds_barrier();
        bf16_t* OG = (bf16_t*)(ws + OFF_OGLA) + (size_t)dir * T_LAT * 512; const size_t row0 = (size_t)b * SEQ + (size_t)(j - 4) * 64;
        bf16x8 vb[2];
#pragma unroll
        for (int ks = 0; ks < 2; ++ks) vb[ks] = ldsfrag(smem, GL_VT + (16 * wid + fr) * 144 + (32 * ks + 8 * fq) * 2);
#pragma unroll
        for (int mt = 0; mt < 4; ++mt) { f32x4 o = Z4;
#pragma unroll
            for (int ks = 0; ks < 2; ++ks) o = mfma16(ldsfrag(smem, GL_ATT + (16 * mt + fr) * 144 + (32 * ks + 8 * fq) * 2), vb[ks], o);
#pragma unroll
            for (int r = 0; r < 4; ++r) OG[(row0 + 16 * mt + 4 * fq + r) * 512 + h * 128 + 16 * wid + fr] = f2bf(o[r]); }
    }
    lds_barrier();
    }
#undef GLAPRE_LOAD
}
constexpr int GS2_QD = 0, GS2_KDT = 9216, GS2_VT = 18432, GS2_ST = 36864;
DI void gla_scan_chain(const Params& p, unsigned char* smem, int cid, int half) {
    const int tid = threadIdx.x, lane = tid & 63, wid = tid >> 6, fr = lane & 15, fq = lane >> 4;
    const int b = cid >> 3, h = (cid >> 1) & 3, dir = cid & 1;
    unsigned char* ws = p.ws;
    const bf16_t* P2 = (const bf16_t*)(ws + OFF_P2);
    bf16_t* OG = (bf16_t*)(ws + OFF_OGLA) + (size_t)dir * T_LAT * 512;
    const int cw = wid & 3, ecol0 = half * 64 + 16 * cw;
    const int STo = GS2_ST + cw * 2304;
    f32x4 S[4];
#pragma unroll
    for (int i = 0; i < 4; ++i) S[i] = Z4;
    if (wid < 4) for (int i = lane; i < 2304 / 16; i += 64) *(u32x4*)(smem + STo + i * 16) = (u32x4){0u, 0u, 0u, 0u};
    struct Pf { u32x4 rq, rk, rv[2]; f32x4 rgl[4]; bf16_t ro[16]; };
    Pf pfA, pfB;
#define GLA2_PREFETCH(PF, jn) do { const int item_ = (((b * 132 + (jn)) * 4 + h) * 2) + dir; const size_t r0_ = chunk_row0(b, (jn)); \
        (PF).rk = *(const u32x4*)((const bf16_t*)(ws + OFF_GKDT) + (size_t)item_ * 4096 + (tid >> 3) * 64 + (tid & 7) * 8); \
        _Pragma("unroll") for (int q_ = 0; q_ < 2; ++q_) { const int pid_ = tid + 512 * q_; (PF).rv[q_] = *(const u32x4*)(P2 + (r0_ + (pid_ & 63)) * 2048 + 1024 + h * 128 + (pid_ >> 6) * 8); } \
        _Pragma("unroll") for (int md_ = 0; md_ < 4; ++md_) (PF).rgl[md_] = *(const f32x4*)((const float*)(ws + OFF_GGL) + (size_t)item_ * 64 + 16 * md_ + 4 * fq); \
        if ((jn) >= 4) { const int lit_ = ((b * 128 + ((jn) - 4)) * 4 + h) * 2 + dir; (PF).rq = *(const u32x4*)((const bf16_t*)p.out + DOUT_GQD + (size_t)lit_ * 4096 + (tid >> 3) * 64 + (tid & 7) * 8); \
            const size_t row0_ = (size_t)b * SEQ + (size_t)((jn) - 4) * 64; \
            _Pragma("unroll") for (int i_ = 0; i_ < 16; ++i_) (PF).ro[i_] = OG[(row0_ + 16 * (i_ >> 2) + 4 * fq + (i_ & 3)) * 512 + h * 128 + ecol0 + fr]; } } while (0)
    GLA2_PREFETCH(pfA, dir ? 3 : 0); GLA2_PREFETCH(pfB, dir ? 2 : 1);
    unsigned pfv = 0u, pfacc = 0u;
#define GLA2_WARM(jn) do { const int item_ = (((b * 132 + (jn)) * 4 + h) * 2) + dir; const size_t r0_ = chunk_row0(b, (jn)); const bf16_t* a_ = nullptr; \
        if (tid < 64) a_ = (const bf16_t*)(ws + OFF_GKDT) + (size_t)item_ * 4096 + tid * 64; \
        else if (tid < 128) { if ((jn) >= 4) a_ = (const bf16_t*)p.out + DOUT_GQD + (size_t)(((b * 128 + ((jn) - 4)) * 4 + h) * 2 + dir) * 4096 + (tid - 64) * 64; } \
        else if (tid < 256) a_ = P2 + (r0_ + ((tid - 128) >> 1)) * 2048 + 1024 + h * 128 + ((tid - 128) & 1) * 64; \
        else if (tid < 384) { if ((jn) >= 4) a_ = OG + ((size_t)b * SEQ + (size_t)((jn) - 4) * 64 + ((tid - 256) >> 1)) * 512 + h * 128 + ((tid - 256) & 1) * 64; } \
        else if (tid < 386) a_ = (const bf16_t*)((const float*)(ws + OFF_GGL) + (size_t)item_ * 64 + (tid - 384) * 32); \
        if (a_) pfv = *(const unsigned*)a_; } while (0)
    auto step = [&](Pf& pf, const int s) __attribute__((always_inline)) {
        const int j = dir ? (s < 4 ? 3 - s : 135 - s) : s;
        if (j >= 4) *(u32x4*)(smem + GS2_QD + (tid >> 3) * 144 + (tid & 7) * 16) = pf.rq;
        *(u32x4*)(smem + GS2_KDT + (tid >> 3) * 144 + (tid & 7) * 16) = pf.rk;
#pragma unroll
        for (int q = 0; q < 2; ++q) { const int pid = tid + 512 * q, c = pid & 63, e0 = (pid >> 6) * 8;
#pragma unroll
            for (int e = 0; e < 4; ++e) { *(bf16_t*)(smem + GS2_VT + (e0 + 2 * e) * 144 + c * 2) = (bf16_t)(pf.rv[q][e] & 0xffffu); *(bf16_t*)(smem + GS2_VT + (e0 + 2 * e + 1) * 144 + c * 2) = (bf16_t)(pf.rv[q][e] >> 16); } }
        f32x4 glv[4]; f32x4 o[4];
#pragma unroll
        for (int md = 0; md < 4; ++md) glv[md] = pf.rgl[md];
#pragma unroll
        for (int mt = 0; mt < 4; ++mt) o[mt] = (f32x4){bf2f(pf.ro[4 * mt]), bf2f(pf.ro[4 * mt + 1]), bf2f(pf.ro[4 * mt + 2]), bf2f(pf.ro[4 * mt + 3])};
        lds_barrier();
        if (s + 2 < 132) { const int jn = dir ? (s + 2 < 4 ? 3 - (s + 2) : 135 - (s + 2)) : s + 2; GLA2_PREFETCH(pf, jn); }
        if (wid < 4) {
        __builtin_amdgcn_s_setprio(2);
        if (j >= 4) { const size_t row0 = (size_t)b * SEQ + (size_t)(j - 4) * 64;
            bf16x8 sb[2];
#pragma unroll
            for (int ks = 0; ks < 2; ++ks) sb[ks] = ldsfrag(smem, STo + fr * 144 + (32 * ks + 8 * fq) * 2);
#pragma unroll
            for (int mt = 0; mt < 4; ++mt) {
#pragma unroll
                for (int ks = 0; ks < 2; ++ks) o[mt] = mfma16(ldsfrag(smem, GS2_QD + (16 * mt + fr) * 144 + (32 * ks + 8 * fq) * 2), sb[ks], o[mt]);
#pragma unroll
                for (int r = 0; r < 4; ++r) OG[(row0 + 16 * mt + 4 * fq + r) * 512 + h * 128 + ecol0 + fr] = f2bf(o[mt][r]); } }
        bf16x8 vb[2];
#pragma unroll
        for (int ks = 0; ks < 2; ++ks) vb[ks] = ldsfrag(smem, GS2_VT + (ecol0 + fr) * 144 + (32 * ks + 8 * fq) * 2);
#pragma unroll
        for (int md = 0; md < 4; ++md) { f32x4 a = S[md] * glv[md];
#pragma unroll
            for (int ks = 0; ks < 2; ++ks) a = mfma16(ldsfrag(smem, GS2_KDT + (16 * md + fr) * 144 + (32 * ks + 8 * fq) * 2), vb[ks], a);
            S[md] = a;
            u32x2 w; w.x = cvt_pk_bf16(a[0], a[1]); w.y = cvt_pk_bf16(a[2], a[3]); *(u32x2*)(smem + STo + fr * 144 + (16 * md + 4 * fq) * 2) = w; }
        __builtin_amdgcn_s_setprio(0);
        }
        lds_barrier();
    };
    for (int s2 = 0; s2 < 132; s2 += 2) { step(pfA, s2); step(pfB, s2 + 1); }
#undef GLA2_PREFETCH
#undef GLA2_WARM
    asm volatile("" :: "v"(pfacc));
}
DI void merge_phase(const Params& p) {
    const int lane = threadIdx.x & 63, wid = threadIdx.x >> 6; unsigned char* ws = p.ws;
    const bf16_t* P2 = (const bf16_t*)(ws + OFF_P2); bf16_t* Y = (bf16_t*)(ws + OFF_Y);
    const int half = lane >> 5, col = (lane & 31) * 16;
    const bf16_t* O0 = (const bf16_t*)(ws + (half ? OFF_OGLA : OFF_OGDN)); const bf16_t* O1 = O0 + (size_t)T_LAT * 512;
    const float* nw = (half ? p.gla_norm_w : p.gdn_norm_w) + (col & 127);
    for (int r = blockIdx.x * 8 + wid; r < T_LAT; r += gridDim.x * 8) {
        float o[16]; float ss = 0.f;
#pragma unroll
        for (int q = 0; q < 2; ++q) { const u32x4 a = __builtin_nontemporal_load((const u32x4*)(O0 + (size_t)r * 512 + col + q * 8)), c = __builtin_nontemporal_load((const u32x4*)(O1 + (size_t)r * 512 + col + q * 8));
#pragma unroll
            for (int e = 0; e < 4; ++e) { const float v0 = bflo(a[e]) + bflo(c[e]), v1 = bfhi(a[e]) + bfhi(c[e]); o[q * 8 + 2 * e] = v0; o[q * 8 + 2 * e + 1] = v1; ss += v0 * v0 + v1 * v1; } }
        ss += __shfl_xor(ss, 1); ss += __shfl_xor(ss, 2); ss += __shfl_xor(ss, 4);
        const float rs = rsqrtf(ss * (1.f / 128.f) + 1e-6f);
        const bf16_t* zp = P2 + (size_t)r * 2048 + (half ? 1536 : 0) + col; u32x4 w[2];
#pragma unroll
        for (int q = 0; q < 2; ++q) { const u32x4 z = __builtin_nontemporal_load((const u32x4*)(zp + q * 8));
#pragma unroll
            for (int e = 0; e < 4; ++e) { const float y0 = o[q * 8 + 2 * e] * rs * nw[q * 8 + 2 * e] * siluf(bflo(z[e])), y1 = o[q * 8 + 2 * e + 1] * rs * nw[q * 8 + 2 * e + 1] * siluf(bfhi(z[e])); w[q][e] = cvt_pk_bf16(y0, y1); } }
        *(u32x4*)(Y + (size_t)r * 1024 + half * 512 + col) = w[0]; *(u32x4*)(Y + (size_t)r * 1024 + half * 512 + col + 8) = w[1];
    }
}
typedef _Float16 h16x2 __attribute__((ext_vector_type(2)));
typedef _Float16 h16x4 __attribute__((ext_vector_type(4)));
typedef f32x2 cf;
DI cf cmul(cf a, cf b) { return (cf){a.x, a.x} * b + (cf){a.y, a.y} * (cf){-b.y, b.x}; }
DI cf cadd(cf a, cf b) { return a + b; }
DI cf csub(cf a, cf b) { return a - b; }
template <int SGN> DI cf mulI(cf a) { return SGN < 0 ? (cf){a.y, -a.x} : (cf){-a.y, a.x}; }
template <int SGN> DI void dft4(cf& a0, cf& a1, cf& a2, cf& a3) {
    const cf s02 = cadd(a0, a2), d02 = csub(a0, a2), s13 = cadd(a1, a3), d13 = mulI<SGN>(csub(a1, a3));
    a0 = cadd(s02, s13); a2 = csub(s02, s13); a1 = cadd(d02, d13); a3 = csub(d02, d13);
}
template <int SGN> DI void dft16(cf (&x)[16]) {
    constexpr float C1 = 0.92387953251128674f, S1 = 0.38268343236508977f, C2 = 0.70710678118654752f;
#pragma unroll
    for (int m1 = 0; m1 < 4; ++m1) dft4<SGN>(x[m1], x[m1 + 4], x[m1 + 8], x[m1 + 12]);
#define TW(idx, c, s) x[idx] = cmul(x[idx], (cf){(c), SGN * (s)})
    TW(1 + 4, C1, S1); TW(1 + 8, C2, C2); TW(1 + 12, S1, C1);
    TW(2 + 4, C2, C2); x[2 + 8] = mulI<SGN>(x[2 + 8]); TW(2 + 12, -C2, C2);
    TW(3 + 4, S1, C1); TW(3 + 8, -C2, C2); TW(3 + 12, -C1, -S1);
#undef TW
#pragma unroll
    for (int k2 = 0; k2 < 4; ++k2) dft4<SGN>(x[4 * k2], x[4 * k2 + 1], x[4 * k2 + 2], x[4 * k2 + 3]);
#pragma unroll
    for (int a = 0; a < 4; ++a)
#pragma unroll
        for (int bb = a + 1; bb < 4; ++bb) { const cf t = x[4 * a + bb]; x[4 * a + bb] = x[4 * bb + a]; x[4 * bb + a] = t; }
}
DI int launder(int v) { asm volatile("" : "+v"(v)); return v; }
DI int fpad(int e) { return e + ((e >> 6) << 2); }
constexpr int FFT_LDS_ELEMS = 16384 + 1024;
template <int SGN> DI void twiddles(float f, cf (&w)[16]) {
    w[1] = (cf){__builtin_amdgcn_cosf(f), SGN * __builtin_amdgcn_sinf(f)}; const float f2 = __builtin_amdgcn_fractf(2.f * f), f4 = __builtin_amdgcn_fractf(4.f * f), f8 = __builtin_amdgcn_fractf(8.f * f);
    w[2] = (cf){__builtin_amdgcn_cosf(f2), SGN * __builtin_amdgcn_sinf(f2)}; w[4] = (cf){__builtin_amdgcn_cosf(f4), SGN * __builtin_amdgcn_sinf(f4)}; w[8] = (cf){__builtin_amdgcn_cosf(f8), SGN * __builtin_amdgcn_sinf(f8)};
    w[3] = cmul(w[2], w[1]); w[5] = cmul(w[4], w[1]); w[6] = cmul(w[4], w[2]); w[7] = cmul(w[4], w[3]);
    w[9] = cmul(w[8], w[1]); w[10] = cmul(w[8], w[2]); w[11] = cmul(w[8], w[3]); w[12] = cmul(w[8], w[4]); w[13] = cmul(w[8], w[5]); w[14] = cmul(w[8], w[6]); w[15] = cmul(w[8], w[7]);
}
template <int SGN, int LGN, int MODE = 0> DI void fft_pass16(cf* X, int tid) {
    constexpr int n = 1 << LGN, st = n >> 4, pst = st >= 64 ? st + ((st >> 6) << 2) : st;
#pragma unroll
    for (int qq = 0; qq < 2; ++qq) { const int q = tid + 512 * qq, blk = q >> (LGN - 4), i = q & (st - 1); cf* xp = X + fpad(blk * n + i);
        cf x[16], w[16];
#pragma unroll
        for (int m = 0; m < 16; ++m) x[m] = (MODE == 1 && m >= 8) ? (cf){0.f, 0.f} : xp[m * pst];
        twiddles<SGN>((float)i * (1.f / (float)n), w);
        if (SGN > 0) {
#pragma unroll
            for (int k = 1; k < 16; ++k) x[k] = cmul(x[k], w[k]); }
        dft16<SGN>(x);
        if (SGN < 0) {
#pragma unroll
            for (int k = 1; k < 16; ++k) x[k] = cmul(x[k], w[k]); }
#pragma unroll
        for (int m = 0; m < 16; ++m) if (!(MODE == 2 && m >= 8)) xp[m * pst] = x[m];
    }
}
template <int SGN> DI void fft_pass4(cf* X, int tid) {
#pragma unroll 2
    for (int qq = 0; qq < 8; ++qq) { const int q = tid + 512 * qq; f32x4* pp = (f32x4*)(X + fpad(4 * q)); f32x4 a = pp[0], b = pp[1];
        cf x0{a[0], a[1]}, x1{a[2], a[3]}, x2{b[0], b[1]}, x3{b[2], b[3]}; dft4<SGN>(x0, x1, x2, x3);
        pp[0] = (f32x4){x0.x, x0.y, x1.x, x1.y}; pp[1] = (f32x4){x2.x, x2.y, x3.x, x3.y}; }
}
DI void fft_fwd(cf* X, int tid) { fft_pass16<-1, 14>(X, launder(tid)); __syncthreads(); fft_pass16<-1, 10>(X, launder(tid)); __syncthreads(); fft_pass16<-1, 6>(X, launder(tid)); __syncthreads(); fft_pass4<-1>(X, launder(tid)); __syncthreads(); }
DI void fft_fwd_hz(cf* X, int tid) { fft_pass16<-1, 14, 1>(X, launder(tid)); __syncthreads(); fft_pass16<-1, 10>(X, launder(tid)); __syncthreads(); fft_pass16<-1, 6>(X, launder(tid)); __syncthreads(); fft_pass4<-1>(X, launder(tid)); __syncthreads(); }
DI void fft_inv_lo(cf* X, int tid) { fft_pass4<1>(X, launder(tid)); __syncthreads(); fft_pass16<1, 6>(X, launder(tid)); __syncthreads(); fft_pass16<1, 10>(X, launder(tid)); __syncthreads(); fft_pass16<1, 14, 2>(X, launder(tid)); __syncthreads(); }
DI void fft_inv(cf* X, int tid) { fft_pass4<1>(X, launder(tid)); __syncthreads(); fft_pass16<1, 6>(X, launder(tid)); __syncthreads(); fft_pass16<1, 10>(X, launder(tid)); __syncthreads(); fft_pass16<1, 14>(X, launder(tid)); __syncthreads(); }

DI void hy_hdn_phase(const Params& p) {
    const int lane = threadIdx.x & 63, wid = threadIdx.x >> 6; bf16_t* HDN = (bf16_t*)(p.ws + OFF_HDN);
    const float frq = p.hy_freq[lane];
    for (int l = blockIdx.x * 8 + wid; l < SEQ; l += gridDim.x * 8) {
        float zv = 0.f;
        if (lane == 0) zv = (float)l / 8191.f;
        else if (lane < 33) { const int bnd = (lane - 1) & 15; const float f = 1e-4f + (float)bnd * ((15.f - 1e-4f) / 15.f), w = (6.283185307179586f / 8192.f) * (float)l; zv = lane < 17 ? cosf(f * w) : -sinf(f * w); }
        float a = p.hy_pos_b1[lane];
        for (int i = 0; i < 33; ++i) a += __shfl(zv, i) * p.hy_pos_w1[i * 64 + lane];
        float h1 = sinf(frq * a);
        a = p.hy_pos_b2[lane];
        for (int i = 0; i < 64; ++i) a += __shfl(h1, i) * p.hy_pos_w2[i * 64 + lane];
        float h2 = sinf(frq * a);
        a = p.hy_pos_b3[lane];
        for (int i = 0; i < 64; ++i) a += __shfl(h2, i) * p.hy_pos_w3[i * 64 + lane];
        HDN[l * 64 + lane] = f2bf(sinf(frq * a));
    }
}
constexpr size_t OFF_FOT = OFF_HDN + MiB;
DI void hy_filt_item(const Params& p, unsigned char* smem, int item) {
    int tid_ = threadIdx.x; asm volatile("" : "+v"(tid_)); const int tid = tid_, lane = tid & 63, wid = tid >> 6, fr = lane & 15, fq = lane >> 4;
    const int lt = item & 15, ct = item >> 4, l0 = lt * 512 + wid * 64, c0 = ct * 64;
    const bf16_t* HD = (const bf16_t*)(p.ws + OFF_HDN); const bf16_t* FT = (const bf16_t*)(p.ws + OFF_FOT); _Float16* HT = (_Float16*)(p.ws + OFF_HT);
    const float dmin = -3.0701134573253944f, dmax = -15.350567286626972f;
    bf16x8 af[4][2];
#pragma unroll
    for (int mt = 0; mt < 4; ++mt)
#pragma unroll
        for (int ks = 0; ks < 2; ++ks) af[mt][ks] = *(const bf16x8*)(HD + (size_t)(l0 + 16 * mt + fr) * 64 + 32 * ks + 8 * fq);
#pragma unroll
    for (int nt = 0; nt < 4; ++nt) { const int c = c0 + 16 * nt + fr; bf16x8 bfr[2];
#pragma unroll
        for (int ks = 0; ks < 2; ++ks) bfr[ks] = *(const bf16x8*)(FT + (size_t)c * 64 + 32 * ks + 8 * fq);
        const float delta = fabsf(dmin + (dmax - dmin) * ((float)(c & 1023) / 1023.f));
#pragma unroll
        for (int mt = 0; mt < 4; ++mt) { f32x4 acc = Z4;
#pragma unroll
            for (int ks = 0; ks < 2; ++ks) acc = mfma16(af[mt][ks], bfr[ks], acc);
            const int l = l0 + 16 * mt + 4 * fq; _Float16 o[4];
#pragma unroll
            for (int r = 0; r < 4; ++r) o[r] = (_Float16)(acc[r] * (__expf(-((float)(l + r) / 8191.f) * delta) + 0.05f));
            *(u32x2*)(HT + (size_t)c * SEQ + l) = __builtin_bit_cast(u32x2, *(const h16x4*)o); } }
}
DI int fft_pos2freq(int p) { return (p >> 10) + (((p >> 6) & 15) << 4) + (((p >> 2) & 15) << 8) + ((p & 3) << 12); }
DI int fft_freq2pos(int f) { return ((f & 15) << 10) + (((f >> 4) & 15) << 6) + (((f >> 8) & 15) << 2) + (f >> 12); }
DI void hy_spec_item(const Params& p, unsigned char* smem, int item) {
    int tid_ = threadIdx.x; asm volatile("" : "+v"(tid_)); const int tid = tid_, d = item; cf* X = (cf*)smem;
    const _Float16* HTp = (const _Float16*)(p.ws + OFF_HT);
    const _Float16* hf0 = HTp + (size_t)d * SEQ; const _Float16* hf1 = HTp + (size_t)(1024 + d) * SEQ; const _Float16* hb0 = HTp + (size_t)(2048 + d) * SEQ; const _Float16* hb1 = HTp + (size_t)(3072 + d) * SEQ;
    for (int m = tid; m < SEQ; m += 512) { X[fpad(m)] = (cf){(float)hf0[m], (float)hf1[m]}; X[fpad(m == 0 ? 8192 : 16384 - m)] = m == 0 ? (cf){0.f, 0.f} : (cf){(float)hb0[m], (float)hb1[m]}; }
    __syncthreads();
    fft_fwd(X, tid);
    h16x2* SP0 = (h16x2*)(p.ws + OFF_SPEC) + (size_t)d * 16384; h16x2* SP1 = SP0 + (size_t)1024 * 16384;
    for (int e = tid; e < 16384; e += 512) { const int f = fft_pos2freq(e), e2 = fft_freq2pos((16384 - f) & 16383); const cf z = X[fpad(e)], zm = X[fpad(e2)];
        h16x2 o0, o1; o0.x = (_Float16)(0.5f * (z.x + zm.x) + p.hy_skip[d]); o0.y = (_Float16)(0.5f * (z.y - zm.y)); o1.x = (_Float16)(0.5f * (z.y + zm.y) + p.hy_skip[1024 + d]); o1.y = (_Float16)(-0.5f * (z.x - zm.x));
        SP0[e] = o0; SP1[e] = o1; }
    __syncthreads();
}
DI void hy_sc8(const bf16_t* row, int t, float w0, float w1, float w2, float (&o)[8]) {
    const u32x4 v = *(const u32x4*)(row + t); float x[10]; x[0] = t > 0 ? bf2f(row[t - 1]) : 0.f; x[9] = t + 8 < SEQ ? bf2f(row[t + 8]) : 0.f;
#pragma unroll
    for (int e = 0; e < 4; ++e) { x[1 + 2 * e] = bflo(v[e]); x[2 + 2 * e] = bfhi(v[e]); }
#pragma unroll
    for (int i = 0; i < 8; ++i) o[i] = w0 * x[i] + w1 * x[i + 1] + w2 * x[i + 2];
}
DI void hy_spec_load(const h16x2* SP, int tid, h16x2 (&kr)[32]) {
#pragma unroll
    for (int u = 0; u < 32; ++u) kr[u] = SP[tid + 512 * u];
}
DI void hy_spec_mul(cf* X, const h16x2 (&kr)[32], int tid) {
#pragma unroll
    for (int u = 0; u < 32; ++u) { cf* xp = X + fpad(tid + 512 * u); *xp = cmul(*xp, (cf){(float)kr[u].x * (1.f / 16384.f), (float)kr[u].y * (1.f / 16384.f)}); }
    __syncthreads();
}
DI void hy_conv_item(const Params& p, unsigned char* smem, int item) {
    int tid_ = threadIdx.x; asm volatile("" : "+v"(tid_)); const int tid = tid_, d = item >> 1, pair = item & 1; cf* X = (cf*)smem;
    const bf16_t* UT = (const bf16_t*)(p.ws + OFF_UT); bf16_t* ZT = (bf16_t*)(p.ws + OFF_ZT);
    const h16x2* SP0 = (const h16x2*)(p.ws + OFF_SPEC) + (size_t)d * 16384; const h16x2* SP1 = SP0 + (size_t)1024 * 16384;
    const float* cw = p.hy_conv_w;
    const size_t boff = (size_t)pair * 2 * SEQ;
    bf16_t* o0 = ZT + (size_t)d * T_LAT + boff; bf16_t* o1 = o0 + SEQ;
    { const float w0 = cw[d], w1 = cw[3072 + d], w2 = cw[6144 + d]; const bf16_t* r0 = UT + (size_t)d * T_LAT + boff; const bf16_t* r1 = r0 + SEQ;
#pragma unroll
      for (int q = 0; q < 2; ++q) { const int t = 8 * (tid + 512 * q); float a0[8], a1[8]; hy_sc8(r0, t, w0, w1, w2, a0); hy_sc8(r1, t, w0, w1, w2, a1);
          f32x4* xp = (f32x4*)(X + fpad(t));
#pragma unroll
          for (int i = 0; i < 4; ++i) { xp[i] = (f32x4){a0[2 * i], a1[2 * i], a0[2 * i + 1], a1[2 * i + 1]}; } } }
    __syncthreads();
    { h16x2 kr[32]; hy_spec_load(SP0, tid, kr); fft_fwd_hz(X, launder(tid)); hy_spec_mul(X, kr, launder(tid)); }
    fft_inv_lo(X, launder(tid));
    { const int ch = 1024 + d; const float w0 = cw[ch], w1 = cw[3072 + ch], w2 = cw[6144 + ch]; const bf16_t* r0 = UT + (size_t)ch * T_LAT + boff; const bf16_t* r1 = r0 + SEQ;
#pragma unroll
      for (int q = 0; q < 2; ++q) { const int t = 8 * (tid + 512 * q); float g0[8], g1[8]; hy_sc8(r0, t, w0, w1, w2, g0); hy_sc8(r1, t, w0, w1, w2, g1);
          f32x4* xp = (f32x4*)(X + fpad(t));
#pragma unroll
          for (int i = 0; i < 4; ++i) { const f32x4 y = xp[i]; xp[i] = (f32x4){y[0] * g0[2 * i], y[1] * g1[2 * i], y[2] * g0[2 * i + 1], y[3] * g1[2 * i + 1]}; } } }
    __syncthreads();
    { h16x2 kr[32]; hy_spec_load(SP1, tid, kr); fft_fwd_hz(X, launder(tid)); hy_spec_mul(X, kr, launder(tid)); }
    fft_inv_lo(X, launder(tid));
    { const int ch = 2048 + d; const float w0 = cw[ch], w1 = cw[3072 + ch], w2 = cw[6144 + ch]; const bf16_t* r0 = UT + (size_t)ch * T_LAT + boff; const bf16_t* r1 = r0 + SEQ;
#pragma unroll
      for (int q = 0; q < 2; ++q) { const int t = 8 * (tid + 512 * q); float g0[8], g1[8]; hy_sc8(r0, t, w0, w1, w2, g0); hy_sc8(r1, t, w0, w1, w2, g1);
          const f32x4* xp = (const f32x4*)(X + fpad(t)); u32x4 s0, s1;
#pragma unroll
          for (int i = 0; i < 4; ++i) { const f32x4 y = xp[i]; s0[i] = cvt_pk_bf16(y[0] * g0[2 * i], y[2] * g0[2 * i + 1]); s1[i] = cvt_pk_bf16(y[1] * g1[2 * i], y[3] * g1[2 * i + 1]); }
          *(u32x4*)(o0 + t) = s0; *(u32x4*)(o1 + t) = s1; } }
    __syncthreads();
}
DI void hy_transpose_phase(const Params& p, unsigned char* smem) {
    const int tid = threadIdx.x; const bf16_t* ZT = (const bf16_t*)(p.ws + OFF_ZT); bf16_t* Z = (bf16_t*)(p.ws + OFF_Z); bf16_t* tl = (bf16_t*)smem;
    for (int u = blockIdx.x; u < 16 * 512; u += gridDim.x) { const int ct = u & 15, tt = u >> 4, r = tid >> 3, pc = tid & 7;
        const u32x4 v = *(const u32x4*)(ZT + (size_t)(ct * 64 + r) * T_LAT + tt * 64 + pc * 8);
#pragma unroll
        for (int e = 0; e < 4; ++e) { tl[(pc * 8 + 2 * e) * 72 + r] = (bf16_t)(v[e] & 0xffffu); tl[(pc * 8 + 2 * e + 1) * 72 + r] = (bf16_t)(v[e] >> 16); }
        __syncthreads();
        *(u32x4*)(Z + (size_t)(tt * 64 + r) * 1024 + ct * 64 + pc * 8) = *(const u32x4*)(tl + r * 72 + pc * 8);
        __syncthreads(); }
}
template <int LAYER> DI void ffn_block(const Params& p, unsigned char* smem, const XcdBarrier& xb) {
    unsigned char* ws = p.ws; const float* mv = (const float*)(ws + OFF_MODV) + (size_t)LAYER * 5 * 6144; bf16_t* Abuf = (bf16_t*)(ws + OFF_A);
    norm_phase(p.out, nullptr, Abuf, T_LAT, p.norm2_w + LAYER * 1024, mv, 3072, 4096);
    xcd_barrier(xb);
    { pg8::EpiSwiglu E{(bf16_t*)(ws + OFF_HID)}; run_gemm(smem, Abuf, (const bf16_t*)(ws + (LAYER ? OFF_W1_F1 : OFF_W0_F1)), T_LAT, 5632, 1024, E); }
    xcd_barrier(xb);
    { pg8::EpiResid E{p.out, p.out, mv + 5120}; run_gemm(smem, (const bf16_t*)(ws + OFF_HID), (const bf16_t*)(ws + (LAYER ? OFF_W1_F2 : OFF_W0_F2)), T_LAT, 1024, 2816, E); }
    xcd_barrier(xb);
}
__global__ void __launch_bounds__(512) mega(Params p) {
    extern __shared__ __attribute__((aligned(16))) unsigned char smem[];
    cg::grid_group grid = cg::this_grid();
    if (threadIdx.x < 4) ((volatile LAS unsigned*)(smem + LDS_XB_ST))[threadIdx.x] = 0u;
    __syncthreads();
    const XcdBarrier xb = xcd_barrier_post((unsigned*)(p.ws + OFF_BAR), (volatile LAS unsigned*)(smem + LDS_XB_ST));
    unsigned char* ws = p.ws;
    float* modv = (float*)(ws + OFF_MODV);
    bf16_t* Abuf = (bf16_t*)(ws + OFF_A);
    { int cb = 0;
      cb = conv_job(cb, (bf16_t*)(ws + OFF_W0_ABIN), 1024, 3840, 1, p.ab_w_in, nullptr, 3632);
      cb = conv_job(cb, (bf16_t*)(ws + OFF_W0_ABOUT), 1024, 1024, 0, p.ab_w_out, nullptr, 1024);
      cb = conv_job(cb, (bf16_t*)(ws + OFF_W0_F1), 1024, 5632, 2, p.ffn_w1, p.ffn_w3, 2816);
      cb = conv_job(cb, (bf16_t*)(ws + OFF_W0_F2), 2816, 1024, 0, p.ffn_w2, nullptr, 1024);
      cb = conv_job(cb, (bf16_t*)(ws + OFF_HDN + MiB), 64, 4096, 0, p.hy_filt_out, nullptr, 4096);
      for (int it = blockIdx.x; it < 192; it += gridDim.x) modvec_item(p, it, (float*)smem);
      hy_hdn_phase(p); }
    if (p.out == nullptr) grid.sync();
    xcd_barrier(xb);
    norm_phase(p.x, p.ctx, Abuf, T_ALL, p.norm1_w, modv, 0, 1024);
    xcd_barrier(xb);
    { pg8::EpiAbIn E{(bf16_t*)(ws + OFF_R), (bf16_t*)(ws + OFF_P2), (float*)(ws + OFF_G)}; run_gemm(smem, Abuf, (const bf16_t*)(ws + OFF_W0_ABIN), T_ALL, 3840, 1024, E); }
    xcd_barrier(xb);
    for (int it = blockIdx.x; it < 2112; it += gridDim.x) gdn_prep_item(p, smem, it);
    xcd_barrier(xb);
    gla_pre_phase(p, smem);
    xcd_barrier(xb);
    if (blockIdx.x < 128) gdn_scan_chain(p, smem, blockIdx.x >> 2, blockIdx.x & 3);
    else if (blockIdx.x < 192) gla_scan_chain(p, smem, (blockIdx.x - 128) >> 1, (blockIdx.x - 128) & 1);
    xcd_barrier(xb);
    merge_phase(p);
    { int cb = 0;
      cb = conv_job(cb, (bf16_t*)(ws + OFF_W1_HYIN), 1024, 3072, 0, p.hy_w_in, nullptr, 3072);
      cb = conv_job(cb, (bf16_t*)(ws + OFF_W1_HYOUT), 1024, 1024, 0, p.hy_w_out, nullptr, 1024);
      cb = conv_job(cb, (bf16_t*)(ws + OFF_W1_F1), 1024, 5632, 2, p.ffn_w1 + (size_t)1024 * 2816, p.ffn_w3 + (size_t)1024 * 2816, 2816);
      cb = conv_job(cb, (bf16_t*)(ws + OFF_W1_F2), 2816, 1024, 0, p.ffn_w2 + (size_t)2816 * 1024, nullptr, 1024); }
    xcd_barrier(xb);
    { pg8::EpiResid E{p.out, p.x, modv + 2048}; run_gemm(smem, (const bf16_t*)(ws + OFF_Y), (const bf16_t*)(ws + OFF_W0_ABOUT), T_LAT, 1024, 1024, E); }
    xcd_barrier(xb);
    ffn_block<0>(p, smem, xb);
    norm_phase(p.out, nullptr, Abuf, T_LAT, p.norm1_w + 1024, modv + 5 * 6144, 0, 1024);
    for (int it = blockIdx.x; it < 1024; it += gridDim.x) hy_filt_item(p, smem, it);
    xcd_barrier(xb);
    for (int it = blockIdx.x; it < 1024; it += gridDim.x) hy_spec_item(p, smem, it);
    xcd_barrier(xb);
    { pg8::EpiBf16Plain E{(bf16_t*)(ws + OFF_UT), (size_t)T_LAT}; run_gemm(smem, (const bf16_t*)(ws + OFF_W1_HYIN), Abuf, 3072, T_LAT, 1024, E); }
    xcd_barrier(xb);
    for (int it = blockIdx.x; it < 2048; it += gridDim.x) hy_conv_item(p, smem, it);
    xcd_barrier(xb);
    hy_transpose_phase(p, smem);
    xcd_barrier(xb);
    { pg8::EpiResid E{p.out, p.out, modv + 5 * 6144 + 2048}; run_gemm(smem, (const bf16_t*)(ws + OFF_Z), (const bf16_t*)(ws + OFF_W1_HYOUT), T_LAT, 1024, 1024, E); }
    xcd_barrier(xb);
    ffn_block<1>(p, smem, xb);
    final_norm_phase(p.out, p.final_norm_w);
}
extern "C" void kernel_launch(void* const* d_in, const int* in_sizes, int n_in, void* d_out, int out_size, void* d_ws, size_t ws_size, hipStream_t stream) {
    static int grid = 0;
    if (grid == 0) {
        int dev = 0, cus = 0, per_cu = 0;
        if (n_in != 33 || ws_size < WS_NEED) { fprintf(stderr, "kernel_launch: unexpected n_in %d / ws %zu (need %zu)\n", n_in, ws_size, (size_t)WS_NEED); grid = -1; return; }
        (void)hipGetDevice(&dev); (void)hipDeviceGetAttribute(&cus, hipDeviceAttributeMultiprocessorCount, dev);
        if (hipFuncSetAttribute((const void*)mega, hipFuncAttributeMaxDynamicSharedMemorySize, LDS_BYTES) != hipSuccess) { fprintf(stderr, "hipFuncSetAttribute failed\n"); grid = -1; return; }
        (void)hipOccupancyMaxActiveBlocksPerMultiprocessor(&per_cu, (const void*)mega, 512, LDS_BYTES);
        if (per_cu < 1) { fprintf(stderr, "occupancy query says %d blocks/CU\n", per_cu); per_cu = 1; }
        (void)hipGetLastError();
        grid = cus;
    }
    if (grid < 0) return;
    Params p{};
    const float** pp = (const float**)&p;
    for (int i = 0; i < 33; ++i) pp[i] = (const float*)d_in[i];
    p.out = (float*)d_out; p.ws = (unsigned char*)d_ws;
    if (hipMemsetAsync((char*)d_ws + OFF_BAR, 0, XCD_BAR_WORDS * sizeof(unsigned), stream) != hipSuccess) { fprintf(stderr, "memset of barrier words failed\n"); return; }
    void* args[] = {&p};
    hipError_t e = hipLaunchCooperativeKernel((const void*)mega, dim3(grid), dim3(512), args, LDS_BYTES, stream);
    if (e != hipSuccess) fprintf(stderr, "cooperative launch failed: %s (grid %d)\n", hipGetErrorString(e), grid);
}
```
